# Optimizing an MI355X kernel written in HIP

```python
import jax, jax.numpy as jnp
from jax import lax
import numpy as np

D_MODEL = 1024
BATCH = 8
SEQ = 4096
DEPTH = 2
DEC_BATCH = 8
DEC_SEQ = 16
PAST_LEN = 2048

CHUNK = 64
Q_BLOCK = 128
HEAD_DIM = 64
FOX_HEADS = 4
SB_HEADS = 4
MLA_HEADS = 8
FOX_WIDTH = FOX_HEADS * HEAD_DIM
SB_WIDTH = SB_HEADS * HEAD_DIM
MLA_NOPE = 64
MLA_ROPE = 32
MLA_V = 64
MLA_WIDTH = MLA_HEADS * MLA_V
Q_LORA = 256
KV_LORA = 128
MIX_WIDTH = FOX_WIDTH + SB_WIDTH + MLA_WIDTH
IN_SPLITS = (FOX_WIDTH, FOX_WIDTH, FOX_WIDTH, FOX_HEADS, FOX_WIDTH,
             SB_WIDTH, SB_WIDTH, SB_WIDTH, SB_WIDTH,
             Q_LORA, KV_LORA, MLA_ROPE, MLA_WIDTH)
IN_WIDTH = sum(IN_SPLITS)
ROPE_THETA = 10000.0
EPS = 1e-6

kernel_name = 'hybrid_fox_sb_mla_stream_step'


def rmsnorm(x, g):
    xf = x.astype(jnp.float32)
    y = xf * lax.rsqrt(jnp.mean(xf * xf, axis=-1, keepdims=True) + EPS)
    return (y * g.astype(jnp.float32)).astype(x.dtype)


def rope(x, pos):
    half = MLA_ROPE // 2
    inv = ROPE_THETA ** (-jnp.arange(half, dtype=jnp.float32) / half)
    ang = pos.astype(jnp.float32)[:, None] * inv[None, :]
    cos = jnp.cos(ang)[None, :, None, :]
    sin = jnp.sin(ang)[None, :, None, :]
    xf = x.astype(jnp.float32)
    x1, x2 = xf[..., :half], xf[..., half:]
    return jnp.concatenate([x1 * cos - x2 * sin, x2 * cos + x1 * sin], axis=-1).astype(x.dtype)


def fox_attend(q, fq, k, v, fk, q_pos, k_pos):
    s = jnp.einsum('bqhd,bkhd->bhqk', q, k).astype(jnp.float32) * HEAD_DIM ** -0.5
    s = s + jnp.transpose(fq, (0, 2, 1))[..., None] - jnp.transpose(fk, (0, 2, 1))[:, :, None, :]
    mask = k_pos[None, :] <= q_pos[:, None]
    p = jax.nn.softmax(jnp.where(mask, s, -jnp.inf), axis=-1)
    return jnp.einsum('bhqk,bkhd->bqhd', p.astype(v.dtype), v)


def sb_attend(q, k, v, q_pos, k_pos):
    z = jnp.einsum('bqhd,bkhd->bhqk', q, k).astype(jnp.float32) * HEAD_DIM ** -0.5
    mask = k_pos[None, :] < q_pos[:, None]
    log_1m = jnp.where(mask, jax.nn.log_sigmoid(-z), 0.0)
    between = lax.cumsum(log_1m, axis=3, reverse=True) - log_1m
    a = jnp.where(mask, jnp.exp(jax.nn.log_sigmoid(z) + between), 0.0)
    return jnp.einsum('bhqk,bkhd->bqhd', a.astype(v.dtype), v)


def mla_attend(q_lat, q_rope, ckv, kpe, q_pos, k_pos):
    s = (jnp.einsum('bqhc,bkc->bhqk', q_lat, ckv)
         + jnp.einsum('bqhr,bkr->bhqk', q_rope, kpe)).astype(jnp.float32) * (MLA_NOPE + MLA_ROPE) ** -0.5
    mask = (k_pos[None, :] // CHUNK) <= (q_pos[:, None] // CHUNK)
    p = jax.nn.softmax(jnp.where(mask, s, -jnp.inf), axis=-1)
    return jnp.einsum('bhqk,bkc->bqhc', p.astype(ckv.dtype), ckv)


def sweep(attend, q_args, k_args, q_pos, k_pos):
    n_q = q_pos.shape[0]
    past = k_pos.shape[0] - n_q
    outs = []
    for start in range(0, n_q, Q_BLOCK):
        stop = min(start + Q_BLOCK, n_q)
        kend = past + stop
        outs.append(attend(*[a[:, start:stop] for a in q_args], *[a[:, :kend] for a in k_args],
                           q_pos[start:stop], k_pos[:kend]))
    return jnp.concatenate(outs, axis=1)


def layer(x, c, past, g_pre, g_post, w_ada, b_ada, w_in, b_f, g_q_a, w_uq, g_kv_a, w_uk, w_uv, w_out):
    b, s, _ = x.shape
    n_past = 0 if past is None else past[0].shape[1]
    q_pos = n_past + jnp.arange(s, dtype=jnp.int32)
    k_pos = jnp.arange(n_past + s, dtype=jnp.int32)
    mod = jax.nn.silu(c) @ w_ada + b_ada
    shift, scale, gate = jnp.split(mod, 3, axis=-1)
    h = rmsnorm(x, g_pre) * (1 + scale[:, None]) + shift[:, None]
    parts = jnp.split(h @ w_in, np.cumsum(IN_SPLITS)[:-1].tolist(), axis=-1)
    fq, fk, fv, ff, fg, sq, sk, sv, sg, cq, ckv, kpe, mg = parts
    fq = fq.reshape(b, s, FOX_HEADS, HEAD_DIM)
    fk = fk.reshape(b, s, FOX_HEADS, HEAD_DIM)
    fv = fv.reshape(b, s, FOX_HEADS, HEAD_DIM)
    logf = jax.nn.log_sigmoid((ff + b_f).astype(jnp.float32))
    sq = sq.reshape(b, s, SB_HEADS, HEAD_DIM)
    sk = sk.reshape(b, s, SB_HEADS, HEAD_DIM)
    sv = sv.reshape(b, s, SB_HEADS, HEAD_DIM)
    q = (rmsnorm(cq, g_q_a) @ w_uq).reshape(b, s, MLA_HEADS, MLA_NOPE + MLA_ROPE)
    q_rope = rope(q[..., MLA_NOPE:], q_pos)
    q_lat = jnp.einsum('bshn,chn->bshc', q[..., :MLA_NOPE], w_uk)
    ckv = rmsnorm(ckv, g_kv_a)
    kpe = rope(kpe[:, :, None, :], q_pos)[:, :, 0]
    new = (fk, fv, logf, sk, sv, ckv, kpe)
    if past is None:
        full = new
    else:
        full = tuple(jnp.concatenate([p_, n_], axis=1) for p_, n_ in zip(past, new))
    k_fk, k_fv, k_logf, k_sk, k_sv, k_ckv, k_kpe = full
    F = jnp.cumsum(k_logf.astype(jnp.float32), axis=1)
    o_fox = sweep(fox_attend, (fq, F[:, n_past:]), (k_fk, k_fv, F), q_pos, k_pos)
    o_sb = sweep(sb_attend, (sq,), (k_sk, k_sv), q_pos, k_pos)
    o_lat = sweep(mla_attend, (q_lat, q_rope), (k_ckv, k_kpe), q_pos, k_pos)
    o_mla = jnp.einsum('bshc,chv->bshv', o_lat, w_uv)
    y = jnp.concatenate([o_fox.reshape(b, s, FOX_WIDTH) * jax.nn.silu(fg),
                         o_sb.reshape(b, s, SB_WIDTH) * jax.nn.silu(sg),
                         o_mla.reshape(b, s, MLA_WIDTH) * jax.nn.silu(mg)], axis=-1) @ w_out
    x = x + gate[:, None] * rmsnorm(y, g_post)
    return x, new


def setup_inputs(seed: int = 0) -> dict:
    key = jax.random.key(seed)
    ks = jax.random.split(key, 32)
    nrm = jax.random.normal
    f32 = jnp.float32
    d = D_MODEL
    return {
        'x_prompt': nrm(ks[0], (BATCH, SEQ, d), f32),
        'x_sample': nrm(ks[1], (DEC_BATCH, DEC_SEQ, d), f32),
        'c_prompt': nrm(ks[2], (BATCH, d), f32),
        'c_sample': nrm(ks[3], (DEC_BATCH, d), f32),
        'cache_fox_k': nrm(ks[4], (DEPTH, DEC_BATCH, PAST_LEN, FOX_HEADS, HEAD_DIM), f32),
        'cache_fox_v': nrm(ks[5], (DEPTH, DEC_BATCH, PAST_LEN, FOX_HEADS, HEAD_DIM), f32),
        'cache_fox_logf': jax.nn.log_sigmoid(nrm(ks[6], (DEPTH, DEC_BATCH, PAST_LEN, FOX_HEADS), f32)),
        'cache_sb_k': nrm(ks[7], (DEPTH, DEC_BATCH, PAST_LEN, SB_HEADS, HEAD_DIM), f32),
        'cache_sb_v': nrm(ks[8], (DEPTH, DEC_BATCH, PAST_LEN, SB_HEADS, HEAD_DIM), f32),
        'cache_mla_ckv': nrm(ks[9], (DEPTH, DEC_BATCH, PAST_LEN, KV_LORA), f32),
        'cache_mla_kpe': nrm(ks[10], (DEPTH, DEC_BATCH, PAST_LEN, MLA_ROPE), f32),
        'g_pre': 1.0 + 0.05 * nrm(ks[11], (DEPTH, d), f32),
        'g_post': 1.0 + 0.05 * nrm(ks[12], (DEPTH, d), f32),
        'w_ada': 0.5 * nrm(ks[13], (DEPTH, d, 3 * d), f32) * d ** -0.5,
        'b_ada': 0.01 * nrm(ks[14], (DEPTH, 3 * d), f32),
        'w_in': nrm(ks[15], (DEPTH, d, IN_WIDTH), f32) * d ** -0.5,
        'b_f': 0.5 * nrm(ks[16], (DEPTH, FOX_HEADS), f32),
        'g_q_a': 1.0 + 0.05 * nrm(ks[17], (DEPTH, Q_LORA), f32),
        'w_uq': nrm(ks[18], (DEPTH, Q_LORA, MLA_HEADS * (MLA_NOPE + MLA_ROPE)), f32) * Q_LORA ** -0.5,
        'g_kv_a': 1.0 + 0.05 * nrm(ks[19], (DEPTH, KV_LORA), f32),
        'w_uk': nrm(ks[20], (DEPTH, KV_LORA, MLA_HEADS, MLA_NOPE), f32) * KV_LORA ** -0.5,
        'w_uv': nrm(ks[21], (DEPTH, KV_LORA, MLA_HEADS, MLA_V), f32) * KV_LORA ** -0.5,
        'w_out': nrm(ks[22], (DEPTH, MIX_WIDTH, d), f32) * MIX_WIDTH ** -0.5,
    }


def reference(x_prompt, x_sample, c_prompt, c_sample, cache_fox_k, cache_fox_v, cache_fox_logf,
              cache_sb_k, cache_sb_v, cache_mla_ckv, cache_mla_kpe,
              g_pre, g_post, w_ada, b_ada, w_in, b_f, g_q_a, w_uq, g_kv_a, w_uk, w_uv, w_out):
    y_prompt = x_prompt
    y_sample = x_sample
    rows_p = []
    rows_s = []
    for l in range(DEPTH):
        w = (g_pre[l], g_post[l], w_ada[l], b_ada[l], w_in[l], b_f[l], g_q_a[l], w_uq[l],
             g_kv_a[l], w_uk[l], w_uv[l], w_out[l])
        y_prompt, new_p = layer(y_prompt, c_prompt, None, *w)
        past = (cache_fox_k[l], cache_fox_v[l], cache_fox_logf[l], cache_sb_k[l], cache_sb_v[l],
                cache_mla_ckv[l], cache_mla_kpe[l])
        y_sample, new_s = layer(y_sample, c_sample, past, *w)
        rows_p.append(new_p)
        rows_s.append(new_s)
    p_fox_k, p_fox_v, p_fox_logf, p_sb_k, p_sb_v, p_mla_ckv, p_mla_kpe = [jnp.stack(t) for t in zip(*rows_p)]
    s_fox_k, s_fox_v, s_fox_logf, s_sb_k, s_sb_v, s_mla_ckv, s_mla_kpe = [jnp.stack(t) for t in zip(*rows_s)]
    return (y_prompt, y_sample,
            p_fox_k, p_fox_v, p_fox_logf, p_sb_k, p_sb_v, p_mla_ckv, p_mla_kpe,
            s_fox_k, s_fox_v, s_fox_logf, s_sb_k, s_sb_v, s_mla_ckv, s_mla_kpe)
```

```cpp
#include <hip/hip_runtime.h>
#include <hip/hip_cooperative_groups.h>
#include <cstdio>
#include <cstdint>
namespace cg = cooperative_groups;
#define REP_ATTN 0
#define REP_GEMM 0

typedef unsigned short u16;
typedef unsigned int u32;
using bf16x8 = __attribute__((ext_vector_type(8))) short;
using f32x16 = __attribute__((ext_vector_type(16))) float;
typedef __bf16 bf16x2_t __attribute__((ext_vector_type(2)));
typedef float f32x2_t __attribute__((ext_vector_type(2)));
#define DI __device__ __forceinline__
#define MFMA(a, b, c) __builtin_amdgcn_mfma_f32_32x32x16_bf16((a), (b), (c), 0, 0, 0)

constexpr int NP = 32768, NSM = 128, R = NP + NSM;
constexpr int T_S = 2112;
constexpr float LOG2E = 1.4426950408889634f;
constexpr float QSC = 0.125f * LOG2E;
constexpr float MSC = 0.10206207261596575f * LOG2E;
constexpr float EPSN = 1e-6f;

constexpr size_t O_Y = 0;
constexpr size_t O_PFK = (size_t)R * 1024;
constexpr size_t O_PFV = O_PFK + 16777216;
constexpr size_t O_PLF = O_PFV + 16777216;
constexpr size_t O_PSK = O_PLF + 262144;
constexpr size_t O_PSV = O_PSK + 16777216;
constexpr size_t O_PCKV = O_PSV + 16777216;
constexpr size_t O_PKPE = O_PCKV + 8388608;
constexpr size_t O_SFK = O_PKPE + 2097152;
constexpr size_t O_SFV = O_SFK + 65536;
constexpr size_t O_SLF = O_SFV + 65536;
constexpr size_t O_SSK = O_SLF + 1024;
constexpr size_t O_SSV = O_SSK + 65536;
constexpr size_t O_SCKV = O_SSV + 65536;
constexpr size_t O_SKPE = O_SCKV + 32768;

constexpr size_t al256(size_t x) { return (x + 255) & ~(size_t)255; }
constexpr size_t WS_CTR = 0;
constexpr size_t WS_BAR = 256;
constexpr size_t WS_KMAX = 256 + 14336;
constexpr size_t WS_SILUC = 256 + 16384;
constexpr size_t WS_MOD = WS_SILUC + 16 * 1024 * 4;
constexpr size_t WS_WIN = WS_MOD + 2 * 16 * 3072 * 4;
constexpr size_t WS_WQ = WS_WIN + (size_t)2 * 3072 * 1024 * 2;
constexpr size_t WS_WKV = WS_WQ + (size_t)2 * 768 * 256 * 2;
constexpr size_t WS_WOUT = WS_WKV + (size_t)2 * 1024 * 128 * 2;
constexpr size_t WS_H = WS_WOUT + (size_t)2 * 1024 * 1024 * 2;
constexpr size_t WS_GATE = WS_H + (size_t)R * 1024 * 2;
constexpr size_t WS_QM = WS_GATE + (size_t)R * 1024 * 2;
constexpr size_t WS_TMP32 = WS_QM;
constexpr size_t WS_CQN = WS_QM + (size_t)R * 1024 * 2;
constexpr size_t WS_QF = WS_CQN + (size_t)R * 256 * 2;
constexpr size_t WS_QS = WS_QF + (size_t)R * 256 * 2;
constexpr size_t WS_KF_P = WS_QS + (size_t)R * 256 * 2;
constexpr size_t WS_KS_P = WS_KF_P + (size_t)NP * 256 * 2;
constexpr size_t WS_VFT_P = WS_KS_P + (size_t)NP * 256 * 2;
constexpr size_t WS_VST_P = WS_VFT_P + (size_t)NP * 256 * 2;
constexpr size_t WS_KN_P = WS_VST_P + (size_t)NP * 256 * 2;
constexpr size_t WS_KPE_P = WS_KN_P + (size_t)NP * 512 * 2;
constexpr size_t WS_VM_P = WS_KPE_P + (size_t)NP * 32 * 2;
constexpr size_t WS_CKVN = WS_VM_P + (size_t)NP * 512 * 2;
constexpr size_t WS_KF_S = WS_CKVN + (size_t)R * 128 * 2;
constexpr size_t WS_KS_S = WS_KF_S + (size_t)8 * T_S * 256 * 2;
constexpr size_t WS_VFT_S = WS_KS_S + (size_t)8 * T_S * 256 * 2;
constexpr size_t WS_VST_S = WS_VFT_S + (size_t)8 * T_S * 256 * 2;
constexpr size_t WS_KN_S = WS_VST_S + (size_t)8 * T_S * 256 * 2;
constexpr size_t WS_KPE_S = WS_KN_S + (size_t)8 * T_S * 512 * 2;
constexpr size_t WS_VM_S = WS_KPE_S + (size_t)8 * T_S * 32 * 2;
constexpr size_t WS_CKVC = WS_VM_S + (size_t)8 * T_S * 512 * 2;
constexpr size_t WS_LOGF = WS_CKVC + (size_t)8 * 2048 * 128 * 2;
constexpr size_t WS_FP = WS_LOGF + (size_t)R * 4 * 4;
constexpr size_t WS_FS = WS_FP + (size_t)8 * 4 * 4096 * 4;
constexpr size_t WS_END = WS_FS + (size_t)8 * 4 * T_S * 4;
static_assert((size_t)R * 416 * 4 <= (size_t)R * 1024 * 2 && (size_t)R * 768 * 2 <= (size_t)R * 1024 * 2, "aliases must fit");
static_assert(WS_END < (size_t)530 * 1000 * 1000, "workspace too large");

struct Params {
  const float* x_prompt; const float* x_sample; const float* c_prompt; const float* c_sample;
  const float* cache_fox_k; const float* cache_fox_v; const float* cache_fox_logf;
  const float* cache_sb_k; const float* cache_sb_v; const float* cache_ckv; const float* cache_kpe;
  const float* g_pre; const float* g_post; const float* w_ada; const float* b_ada; const float* w_in;
  const float* b_f; const float* g_q_a; const float* w_uq; const float* g_kv_a; const float* w_uk;
  const float* w_uv; const float* w_out;
  float* out;
  unsigned char* ws;
};

DI u32 pk2(float a, float b) { f32x2_t v = {a, b}; bf16x2_t r = __builtin_convertvector(v, bf16x2_t); return __builtin_bit_cast(u32, r); }
DI u16 bf1(float a) { return (u16)(pk2(a, 0.f) & 0xffffu); }
DI int crow(int i, int hi) { return (i & 3) + 8 * (i >> 2) + 4 * hi; }
DI float wave_sum(float v) {
#pragma unroll
  for (int o = 32; o > 0; o >>= 1) v += __shfl_xor(v, o);
  return v;
}
DI double shfl_up_d(double x, int o) { int lo = __double2loint(x), hi = __double2hiint(x); lo = __shfl_up(lo, o); hi = __shfl_up(hi, o); return __hiloint2double(hi, lo); }
DI int otid() { int t = threadIdx.x; asm volatile("" : "+v"(t)); return t; }
DI float ex2(float x) { return __builtin_amdgcn_exp2f(x); }
DI float lg2(float x) { return __builtin_amdgcn_logf(x); }
DI float silu_f(float v) { return v * __builtin_amdgcn_rcpf(1.f + __expf(-v)); }
DI float halves_sum(float x) { auto rr = __builtin_amdgcn_permlane32_swap(__float_as_uint(x), __float_as_uint(x), false, false); return __uint_as_float(rr[0]) + __uint_as_float(rr[1]); }
DI float halves_max(float x) { auto rr = __builtin_amdgcn_permlane32_swap(__float_as_uint(x), __float_as_uint(x), false, false); return fmaxf(__uint_as_float(rr[0]), __uint_as_float(rr[1])); }
DI void rope_cs(int pos, int fidx, float& c, float& s) {
  const float inv = ex2(-(float)fidx * (13.287712379549449f / 16.f));
  float rev = ((float)pos * inv) * 0.15915494309189535f;
  rev = rev - floorf(rev);
  s = __builtin_amdgcn_sinf(rev); c = __builtin_amdgcn_cosf(rev);
}

struct Bufs {
  u32* ctr; float* siluc; float* mod; u16* win; u16* wq; u16* wkv; u16* wout; u16* H; u16* GATE; u16* QM; u16* Y; float* TMP32;
  u16* CQN; u16* QF; u16* QS; u16* KF_P; u16* KS_P; u16* VFT_P; u16* VST_P; u16* KN_P; u16* KPE_P; u16* VM_P; u16* CKVN;
  u16* KF_S; u16* KS_S; u16* VFT_S; u16* VST_S; u16* KN_S; u16* KPE_S; u16* VM_S; u16* CKVC; float* LOGF; float* FP; float* FS;
};
DI Bufs make_bufs(unsigned char* ws) {
  Bufs B;
  B.ctr = (u32*)(ws + WS_CTR); B.siluc = (float*)(ws + WS_SILUC); B.mod = (float*)(ws + WS_MOD); B.win = (u16*)(ws + WS_WIN);
  B.wq = (u16*)(ws + WS_WQ); B.wkv = (u16*)(ws + WS_WKV); B.wout = (u16*)(ws + WS_WOUT); B.H = (u16*)(ws + WS_H); B.GATE = (u16*)(ws + WS_GATE);
  B.QM = (u16*)(ws + WS_QM); B.Y = (u16*)(ws + WS_QM); B.TMP32 = (float*)(ws + WS_TMP32); B.CQN = (u16*)(ws + WS_CQN);
  B.QF = (u16*)(ws + WS_QF); B.QS = (u16*)(ws + WS_QS); B.KF_P = (u16*)(ws + WS_KF_P); B.KS_P = (u16*)(ws + WS_KS_P);
  B.VFT_P = (u16*)(ws + WS_VFT_P); B.VST_P = (u16*)(ws + WS_VST_P); B.KN_P = (u16*)(ws + WS_KN_P); B.KPE_P = (u16*)(ws + WS_KPE_P); B.VM_P = (u16*)(ws + WS_VM_P); B.CKVN = (u16*)(ws + WS_CKVN);
  B.KF_S = (u16*)(ws + WS_KF_S); B.KS_S = (u16*)(ws + WS_KS_S); B.VFT_S = (u16*)(ws + WS_VFT_S); B.VST_S = (u16*)(ws + WS_VST_S);
  B.KN_S = (u16*)(ws + WS_KN_S); B.KPE_S = (u16*)(ws + WS_KPE_S); B.VM_S = (u16*)(ws + WS_VM_S); B.CKVC = (u16*)(ws + WS_CKVC); B.LOGF = (float*)(ws + WS_LOGF); B.FP = (float*)(ws + WS_FP); B.FS = (float*)(ws + WS_FS);
  return B;
}


#define XB_TMO      128
#define XB_XCNT(j)  (256  + 64 * (j))
#define XB_XSUB(j)  (1280 + 64 * (j))
#define XB_XGEN(j)  (2304 + 64 * (j))
#define XB_TOP      3328
#define XB_TOPGEN   3392
#define XCD_BAR_WORDS 3456
#define XB_SPIN_CAP (1u << 22)
#define LAS __attribute__((address_space(3)))
DI unsigned xb_ld(unsigned* p) { return __hip_atomic_load(p, __ATOMIC_RELAXED, __HIP_MEMORY_SCOPE_AGENT); }
DI unsigned xb_add(unsigned* p, unsigned v) { return __hip_atomic_fetch_add(p, v, __ATOMIC_RELAXED, __HIP_MEMORY_SCOPE_AGENT); }
DI unsigned xb_xcc_id() { return (unsigned)__builtin_amdgcn_s_getreg((3 << 11) | 20) & 0xFu; }
#define XB_SPIN(cond, bar) do { unsigned _sp = 0; while (cond) { __builtin_amdgcn_s_sleep(1); \
    if ((++_sp & 255u) == 0u) { if (xb_ld(&(bar)[XB_TMO])) break; if (_sp > XB_SPIN_CAP) { atomicAdd(&(bar)[XB_TMO], 1u); break; } } } } while (0)
struct XcdBarrier { unsigned* bar; unsigned x; volatile LAS unsigned* st; };
DI XcdBarrier xcd_barrier_post(unsigned* bar, volatile LAS unsigned* st) {
  XcdBarrier b; b.bar = bar; b.x = xb_xcc_id(); b.st = st;
  if (threadIdx.x == 0) (void)xb_add(&bar[XB_XCNT(b.x)], 1u);
  return b;
}
DI void xcd_barrier_complete(unsigned* bar, unsigned x, unsigned& nloc, unsigned& nx) {
  const unsigned G = gridDim.x * gridDim.y * gridDim.z;
  unsigned sum, cnt, mine, sp = 0u;
  for (;;) {
    sum = 0u; cnt = 0u; mine = 0u;
#pragma unroll
    for (unsigned j = 0; j < 16; ++j) { const unsigned c = xb_ld(&bar[XB_XCNT(j)]); sum += c; cnt += (c > 0u) ? 1u : 0u; mine = (j == x) ? c : mine; }
    if (sum == G) break;
    __builtin_amdgcn_s_sleep(1);
    if ((++sp & 255u) == 0u) { if (xb_ld(&bar[XB_TMO])) break; if (sp > XB_SPIN_CAP) { atomicAdd(&bar[XB_TMO], 1u); break; } }
  }
  nloc = mine > 0u ? mine : 1u; nx = cnt > 0u ? cnt : 1u;
}
DI void xcd_barrier(const XcdBarrier& b) {
  asm volatile("s_waitcnt vmcnt(0)" ::: "memory");
  __syncthreads();
  if (threadIdx.x == 0) {
    unsigned* bar = b.bar;
    __builtin_amdgcn_s_waitcnt(0);
    unsigned nloc = b.st[0], nx = b.st[1];
    if (nloc == 0u) { xcd_barrier_complete(bar, b.x, nloc, nx); b.st[0] = nloc; b.st[1] = nx; }
    const unsigned old = xb_add(&bar[XB_XSUB(b.x)], 1u);
    const unsigned gen = old / nloc;
    if (old + 1u == (gen + 1u) * nloc) {
      __builtin_amdgcn_fence(__ATOMIC_RELEASE, "agent");
      asm volatile("s_waitcnt vmcnt(0)" ::: "memory");
      const unsigned og = xb_add(&bar[XB_TOP], 1u);
      const unsigned tg = og / nx;
      if (og + 1u == (tg + 1u) * nx) xb_add(&bar[XB_TOPGEN], 1u);
      else XB_SPIN(xb_ld(&bar[XB_TOPGEN]) == tg, bar);
      __builtin_amdgcn_fence(__ATOMIC_ACQUIRE, "agent");
      xb_add(&bar[XB_XGEN(b.x)], 1u);
      asm volatile("s_waitcnt vmcnt(0)" ::: "memory");
    } else {
      XB_SPIN(xb_ld(&bar[XB_XGEN(b.x)]) == gen, bar);
      __builtin_amdgcn_fence(__ATOMIC_ACQUIRE, "agent");
      asm volatile("s_waitcnt vmcnt(0)" ::: "memory");
    }
  }
  __syncthreads();
}

DI int in_colmap(int n) { return n < 768 ? n : n < 2432 ? n + 4 : n < 2944 ? n + 36 : n < 2976 ? n - 508 : n < 2980 ? n - 2208 : -1; }

DI void phase_prep(const Params& P, const Bufs& B) {
  const size_t gtid = (size_t)blockIdx.x * 256 + otid(), gsz = (size_t)gridDim.x * 256;
  for (size_t i = gtid; i < 16 * 1024; i += gsz) {
    const float c = i < 8192 ? P.c_prompt[i] : P.c_sample[i - 8192];
    B.siluc[i] = c / (1.f + __expf(-c));
  }
  for (size_t i = gtid; i < (size_t)2 * 128 * 3072; i += gsz) {
    const int n = (int)(i % 3072); const int kc = (int)((i / 3072) % 128); const int l = (int)(i / (3072 * 128));
    const int col = in_colmap(n);
    float v[8];
#pragma unroll
    for (int j = 0; j < 8; ++j) v[j] = col >= 0 ? P.w_in[((size_t)l * 1024 + kc * 8 + j) * 2980 + col] : 0.f;
    uint4 o = {pk2(v[0], v[1]), pk2(v[2], v[3]), pk2(v[4], v[5]), pk2(v[6], v[7])};
    *(uint4*)(B.win + ((size_t)l * 3072 + n) * 1024 + kc * 8) = o;
  }
  for (size_t i = gtid; i < (size_t)2 * 128 * 1024; i += gsz) {
    const int n = (int)(i & 1023); const int kc = (int)((i >> 10) & 127); const int l = (int)(i >> 17);
    float v[8];
#pragma unroll
    for (int j = 0; j < 8; ++j) v[j] = P.w_out[((size_t)l * 1024 + kc * 8 + j) * 1024 + n];
    uint4 o = {pk2(v[0], v[1]), pk2(v[2], v[3]), pk2(v[4], v[5]), pk2(v[6], v[7])};
    *(uint4*)(B.wout + ((size_t)l * 1024 + n) * 1024 + kc * 8) = o;
  }
  for (size_t i = gtid; i < (size_t)2 * 32 * 768; i += gsz) {
    const int n = (int)(i % 768); const int kc = (int)((i / 768) & 31); const int l = (int)(i / (768 * 32));
    float v[8];
#pragma unroll
    for (int j = 0; j < 8; ++j) v[j] = P.w_uq[((size_t)l * 256 + kc * 8 + j) * 768 + n];
    uint4 o = {pk2(v[0], v[1]), pk2(v[2], v[3]), pk2(v[4], v[5]), pk2(v[6], v[7])};
    *(uint4*)(B.wq + ((size_t)l * 768 + n) * 256 + kc * 8) = o;
  }
  for (size_t i = gtid; i < (size_t)2 * 16 * 1024; i += gsz) {
    const int n = (int)(i & 1023); const int kc = (int)((i >> 10) & 15); const int l = (int)(i >> 14);
    const float* srcw = (n < 512 ? P.w_uk : P.w_uv) + (size_t)l * 128 * 512 + (n & 511);
    float v[8];
#pragma unroll
    for (int j = 0; j < 8; ++j) v[j] = srcw[(size_t)(kc * 8 + j) * 512];
    uint4 o = {pk2(v[0], v[1]), pk2(v[2], v[3]), pk2(v[4], v[5]), pk2(v[6], v[7])};
    *(uint4*)(B.wkv + ((size_t)l * 1024 + n) * 128 + kc * 8) = o;
  }
}

DI void phase_mod(const Params& P, const Bufs& B, char* lds) {
  float* sc = (float*)lds;
  const int tid = otid();
  for (int u = blockIdx.x; u < 192; u += gridDim.x) {
    const int l = u / 96, j0 = (u % 96) * 32;
    __syncthreads();
    for (int i = tid; i < 16 * 1024 / 4; i += 256) ((float4*)sc)[i] = ((const float4*)B.siluc)[i];
    __syncthreads();
    const int jj = tid & 31, kq = tid >> 5;
    float acc[16];
#pragma unroll
    for (int i = 0; i < 16; ++i) acc[i] = 0.f;
    const float* wp = P.w_ada + ((size_t)l * 1024 + kq * 128) * 3072 + j0 + jj;
#pragma unroll 4
    for (int k = 0; k < 128; ++k) {
      const float wv = wp[(size_t)k * 3072];
#pragma unroll
      for (int i = 0; i < 16; ++i) acc[i] += sc[i * 1024 + kq * 128 + k] * wv;
    }
    __syncthreads();
    float* red = (float*)lds;
#pragma unroll
    for (int i = 0; i < 16; ++i) red[(kq * 16 + i) * 32 + jj] = acc[i];
    __syncthreads();
    for (int o = tid; o < 512; o += 256) {
      const int i = o >> 5, j = o & 31;
      float s = 0.f;
#pragma unroll
      for (int q = 0; q < 8; ++q) s += red[(q * 16 + i) * 32 + j];
      B.mod[((size_t)l * 16 + i) * 3072 + j0 + j] = s + P.b_ada[l * 3072 + j0 + j];
    }
  }
  __syncthreads();
}

DI void phase_D(const Params& P, const Bufs& B, int l) {
  const int tid_ = otid(); const int lane = tid_ & 63, w = tid_ >> 6;
  for (int row0 = (blockIdx.x * 4 + w) * 2; row0 < R; row0 += gridDim.x * 8) {
    float4 xv[2][4];
    int mi[2];
#pragma unroll
    for (int r = 0; r < 2; ++r) { const int row = row0 + r; mi[r] = row < NP ? (row >> 12) : 8 + ((row - NP) >> 4); }
    if (l == 0) {
#pragma unroll
      for (int r = 0; r < 2; ++r) {
        const int row = row0 + r;
        const float* xin = row < NP ? P.x_prompt + (size_t)row * 1024 : P.x_sample + (size_t)(row - NP) * 1024;
#pragma unroll
        for (int j = 0; j < 4; ++j) xv[r][j] = ((const float4*)xin)[j * 64 + lane];
      }
    } else {
      uint2 yb[2][4]; float4 xo[2][4];
#pragma unroll
      for (int r = 0; r < 2; ++r) {
        const int row = row0 + r;
        const float* xin = row < NP ? P.x_prompt + (size_t)row * 1024 : P.x_sample + (size_t)(row - NP) * 1024;
        const float* xp = (l == 1) ? xin : P.out + O_Y + (size_t)row * 1024;
        const u16* Yr = B.Y + (size_t)row * 1024;
#pragma unroll
        for (int j = 0; j < 4; ++j) { yb[r][j] = ((const uint2*)Yr)[j * 64 + lane]; xo[r][j] = ((const float4*)xp)[j * 64 + lane]; }
      }
      const float* gp = P.g_post + (size_t)(l - 1) * 1024;
#pragma unroll
      for (int r = 0; r < 2; ++r) {
        const int row = row0 + r;
        float4 yv[4]; float ss = 0.f;
#pragma unroll
        for (int j = 0; j < 4; ++j) {
          yv[j].x = __uint_as_float(yb[r][j].x << 16); yv[j].y = __uint_as_float(yb[r][j].x & 0xffff0000u);
          yv[j].z = __uint_as_float(yb[r][j].y << 16); yv[j].w = __uint_as_float(yb[r][j].y & 0xffff0000u);
          ss += yv[j].x * yv[j].x + yv[j].y * yv[j].y + yv[j].z * yv[j].z + yv[j].w * yv[j].w;
        }
        ss = wave_sum(ss);
        const float rs = rsqrtf(ss * (1.f / 1024.f) + EPSN);
        const float* gate = B.mod + ((size_t)(l - 1) * 16 + mi[r]) * 3072 + 2048;
        float* orow = P.out + O_Y + (size_t)row * 1024;
#pragma unroll
        for (int j = 0; j < 4; ++j) {
          const float4 g = ((const float4*)gate)[j * 64 + lane];
          const float4 q = ((const float4*)gp)[j * 64 + lane];
          xv[r][j].x = xo[r][j].x + g.x * (yv[j].x * rs * q.x); xv[r][j].y = xo[r][j].y + g.y * (yv[j].y * rs * q.y);
          xv[r][j].z = xo[r][j].z + g.z * (yv[j].z * rs * q.z); xv[r][j].w = xo[r][j].w + g.w * (yv[j].w * rs * q.w);
          ((float4*)orow)[j * 64 + lane] = xv[r][j];
        }
      }
    }
    if (l < 2) {
      const float* gp = P.g_pre + (size_t)l * 1024;
#pragma unroll
      for (int r = 0; r < 2; ++r) {
        const int row = row0 + r;
        float ss = 0.f;
#pragma unroll
        for (int j = 0; j < 4; ++j) ss += xv[r][j].x * xv[r][j].x + xv[r][j].y * xv[r][j].y + xv[r][j].z * xv[r][j].z + xv[r][j].w * xv[r][j].w;
        ss = wave_sum(ss);
        const float rs = rsqrtf(ss * (1.f / 1024.f) + EPSN);
        const float* md = B.mod + ((size_t)l * 16 + mi[r]) * 3072;
#pragma unroll
        for (int j = 0; j < 4; ++j) {
          const float4 sh = ((const float4*)md)[j * 64 + lane];
          const float4 scl = ((const float4*)(md + 1024))[j * 64 + lane];
          const float4 g = ((const float4*)gp)[j * 64 + lane];
          const float h0 = xv[r][j].x * rs * g.x * (1.f + scl.x) + sh.x, h1 = xv[r][j].y * rs * g.y * (1.f + scl.y) + sh.y;
          const float h2 = xv[r][j].z * rs * g.z * (1.f + scl.z) + sh.z, h3 = xv[r][j].w * rs * g.w * (1.f + scl.w) + sh.w;
          *(uint2*)(B.H + (size_t)row * 1024 + (j * 64 + lane) * 4) = make_uint2(pk2(h0, h1), pk2(h2, h3));
        }
      }
    }
  }
}

constexpr int GP = 72;
template <class Epi, bool SW>
DI void gemm_tile(const u16* __restrict__ A, int lda, const u16* __restrict__ Bt, int ldb, int K, int m0, int n0, char* lds, const Epi& epi) {
  const int tid = otid(), lane = tid & 63, w = __builtin_amdgcn_readfirstlane(tid >> 6), r32 = lane & 31, hi = lane >> 5;
  const int wm = w >> 1, wn = w & 1;
  u16* As0 = (u16*)lds; u16* Bs0 = As0 + 2 * 128 * GP;
  f32x16 acc00, acc01, acc10, acc11;
#pragma unroll
  for (int i = 0; i < 16; ++i) { acc00[i] = 0.f; acc01[i] = 0.f; acc10[i] = 0.f; acc11[i] = 0.f; }
  const int srow = tid >> 3, skc = tid & 7;
  const u16* Ag = A + (size_t)(m0 + srow) * lda + skc * 8;
  const u16* Bg = Bt + (size_t)(n0 + srow) * ldb + skc * 8;
  const size_t a32 = (size_t)32 * lda, b32 = (size_t)32 * ldb;
  uint4 pa0, pa1, pa2, pa3, pb0, pb1, pb2, pb3;
  uint4 qa0, qa1, qa2, qa3, qb0, qb1, qb2, qb3;
#define GLOAD(S, kt_) { const int ko_ = (kt_) * 64; \
    S##a0 = *(const uint4*)(Ag + ko_); S##a1 = *(const uint4*)(Ag + a32 + ko_); S##a2 = *(const uint4*)(Ag + 2 * a32 + ko_); S##a3 = *(const uint4*)(Ag + 3 * a32 + ko_); \
    S##b0 = *(const uint4*)(Bg + ko_); S##b1 = *(const uint4*)(Bg + b32 + ko_); S##b2 = *(const uint4*)(Bg + 2 * b32 + ko_); S##b3 = *(const uint4*)(Bg + 3 * b32 + ko_); }
#define GSTORE(S, st_) { u16* Aw = As0 + (st_) * 128 * GP + srow * GP + skc * 8; u16* Bw = Bs0 + (st_) * 128 * GP + srow * GP + skc * 8; \
    *(uint4*)(Aw) = S##a0; *(uint4*)(Aw + 32 * GP) = S##a1; *(uint4*)(Aw + 64 * GP) = S##a2; *(uint4*)(Aw + 96 * GP) = S##a3; \
    *(uint4*)(Bw) = S##b0; *(uint4*)(Bw + 32 * GP) = S##b1; *(uint4*)(Bw + 64 * GP) = S##b2; *(uint4*)(Bw + 96 * GP) = S##b3; }
#define GCOMPUTE(st_) { const u16* As = As0 + (st_) * 128 * GP; const u16* Bs = Bs0 + (st_) * 128 * GP; \
    _Pragma("unroll") for (int ks = 0; ks < 4; ++ks) { \
      const bf16x8 a0 = *(const bf16x8*)(As + (wm * 64 + r32) * GP + ks * 16 + hi * 8); \
      const bf16x8 a1 = *(const bf16x8*)(As + (wm * 64 + 32 + r32) * GP + ks * 16 + hi * 8); \
      const bf16x8 b0 = *(const bf16x8*)(Bs + (wn * 64 + r32) * GP + ks * 16 + hi * 8); \
      const bf16x8 b1 = *(const bf16x8*)(Bs + (wn * 64 + 32 + r32) * GP + ks * 16 + hi * 8); \
      if (SW) { acc00 = MFMA(b0, a0, acc00); acc01 = MFMA(b1, a0, acc01); acc10 = MFMA(b0, a1, acc10); acc11 = MFMA(b1, a1, acc11); } \
      else { acc00 = MFMA(a0, b0, acc00); acc01 = MFMA(a0, b1, acc01); acc10 = MFMA(a1, b0, acc10); acc11 = MFMA(a1, b1, acc11); } } }
  const int nk = K >> 6;
  GLOAD(p, 0)
  GLOAD(q, 1)
  GSTORE(p, 0)
  __syncthreads();
  for (int kt = 0; kt < nk; kt += 2) {
    if (kt + 2 < nk) GLOAD(p, kt + 2)
    __builtin_amdgcn_sched_barrier(0);
    GCOMPUTE(0)
    GSTORE(q, 1)
    __syncthreads();
    if (kt + 3 < nk) GLOAD(q, kt + 3)
    __builtin_amdgcn_sched_barrier(0);
    GCOMPUTE(1)
    if (kt + 2 < nk) GSTORE(p, 0)
    __syncthreads();
  }
#undef GLOAD
#undef GSTORE
#undef GCOMPUTE
  epi.template run<SW>(m0 + wm * 64, n0 + wn * 64, acc00, r32, hi);
  epi.template run<SW>(m0 + wm * 64, n0 + wn * 64 + 32, acc01, r32, hi);
  epi.template run<SW>(m0 + wm * 64 + 32, n0 + wn * 64, acc10, r32, hi);
  epi.template run<SW>(m0 + wm * 64 + 32, n0 + wn * 64 + 32, acc11, r32, hi);
}

struct EpiIn {
  const Params& P; const Bufs& B; int l;
  template <bool SW>
  DI void run(int rowbase, int colbase, const f32x16 v, int r32, int hi) const {
    const bool samp = rowbase >= NP;
    if (!SW) {
      const u32 rb = (u32)rowbase + 4u * hi;
      const int seg = colbase >> 8; const u32 c = (colbase & 255) + r32;
      const int grp = seg >> 2;
      const u32 ob = samp ? rb - NP : rb;
      float* o = P.out + (samp ? (grp ? O_SSV : O_SFV) + (size_t)l * 32768 : (grp ? O_PSV : O_PFV) + (size_t)l * 8388608) + ob * 256u + c;
      u16* Vb = (u16*)(P.ws + (samp ? (grp ? WS_VST_S : WS_VFT_S) : (grp ? WS_VST_P : WS_VFT_P)));
#pragma unroll
      for (int g = 0; g < 4; ++g) {
#pragma unroll
        for (int j = 0; j < 4; ++j) o[(8 * g + j) * 256] = v[4 * g + j];
        const u32 row0 = rb + 8 * g, orow0 = ob + 8 * g;
        const u32 bb = samp ? (orow0 >> 4) : (row0 >> 12);
        const u32 t0 = samp ? 2048u + (orow0 & 15u) : (row0 & 4095u);
        const u32 T = samp ? T_S : 4096;
        uint2 pkv = {pk2(v[4 * g], v[4 * g + 1]), pk2(v[4 * g + 2], v[4 * g + 3])};
        *(uint2*)(Vb + ((bb * 256u + c) * T + t0)) = pkv;
      }
      return;
    }
    const u32 tok = (u32)rowbase + r32;
    const u32 otok = samp ? tok - NP : tok;
    if (colbase < 2048) {
      const int seg = colbase >> 8; const u32 c0 = (colbase & 255) + 4u * hi;
      const int kind = seg & 3, grp = seg >> 2;
      if (kind == 0) {
        u16* Q = (u16*)(P.ws + (grp ? WS_QS : WS_QF)) + tok * 256u + c0;
#pragma unroll
        for (int g = 0; g < 4; ++g) *(uint2*)(Q + 8 * g) = make_uint2(pk2(v[4 * g] * QSC, v[4 * g + 1] * QSC), pk2(v[4 * g + 2] * QSC, v[4 * g + 3] * QSC));
      } else if (kind == 1) {
        float* o = P.out + (samp ? (grp ? O_SSK : O_SFK) + (size_t)l * 32768 : (grp ? O_PSK : O_PFK) + (size_t)l * 8388608) + otok * 256u + c0;
        const u32 krow_ = samp ? ((otok >> 4) * T_S + 2048u + (otok & 15u)) : tok;
        u16* Kb = (u16*)(P.ws + (samp ? (grp ? WS_KS_S : WS_KF_S) : (grp ? WS_KS_P : WS_KF_P))) + krow_ * 256u + c0;
#pragma unroll
        for (int g = 0; g < 4; ++g) {
          *(float4*)(o + 8 * g) = make_float4(v[4 * g], v[4 * g + 1], v[4 * g + 2], v[4 * g + 3]);
          *(uint2*)(Kb + 8 * g) = make_uint2(pk2(v[4 * g], v[4 * g + 1]), pk2(v[4 * g + 2], v[4 * g + 3]));
        }
        if (grp == 0 && !samp) {
          float ss = 0.f;
#pragma unroll
          for (int i = 0; i < 16; ++i) ss += v[i] * v[i];
#pragma unroll
          for (int o2 = 16; o2 > 0; o2 >>= 1) ss = fmaxf(ss, __shfl_xor(ss, o2));
          if (r32 == 0) {
            const int hh_ = (colbase & 255) >> 6, part = ((colbase >> 5) & 1) * 2 + hi, bb_ = rowbase >> 12;
            atomicMax((u32*)(P.ws + WS_KMAX) + ((l * 8 + bb_) * 4 + hh_) * 4 + part, __float_as_uint(ss));
          }
        }
      } else {
        u16* G = B.GATE + tok * 1024u + grp * 256 + c0;
#pragma unroll
        for (int g = 0; g < 4; ++g) *(uint2*)(G + 8 * g) = make_uint2(pk2(silu_f(v[4 * g]), silu_f(v[4 * g + 1])), pk2(silu_f(v[4 * g + 2]), silu_f(v[4 * g + 3])));
      }
    } else if (colbase < 2432 || colbase == 2944) {
      float* Tp = B.TMP32 + tok * 416u + (colbase == 2944 ? 384 : colbase - 2048) + 4 * hi;
#pragma unroll
      for (int g = 0; g < 4; ++g) *(float4*)(Tp + 8 * g) = make_float4(v[4 * g], v[4 * g + 1], v[4 * g + 2], v[4 * g + 3]);
    } else if (colbase < 2944) {
      u16* G = B.GATE + tok * 1024u + 512 + (colbase - 2432) + 4 * hi;
#pragma unroll
      for (int g = 0; g < 4; ++g) *(uint2*)(G + 8 * g) = make_uint2(pk2(silu_f(v[4 * g]), silu_f(v[4 * g + 1])), pk2(silu_f(v[4 * g + 2]), silu_f(v[4 * g + 3])));
    } else if (colbase == 2976) {
      if (hi == 0) {
        float lf[4];
#pragma unroll
        for (int j = 0; j < 4; ++j) { const float x = v[j] + P.b_f[l * 4 + j]; lf[j] = fminf(x, 0.f) - __logf(1.f + __expf(-fabsf(x))); }
        const float4 o4 = make_float4(lf[0], lf[1], lf[2], lf[3]);
        *(float4*)(P.out + (samp ? O_SLF + (size_t)l * 512 : O_PLF + (size_t)l * 131072) + otok * 4u) = o4;
        *(float4*)(B.LOGF + tok * 4u) = o4;
      }
    }
  }
};

struct EpiQ {
  const Bufs& B;
  template <bool SW>
  DI void run(int rowbase, int colbase, const f32x16 v, int r32, int hi) const {
    const int within = colbase % 96;
    const u32 tok = (u32)rowbase + r32;
    u16* Q = B.QM + tok * 768u + colbase + 4 * hi;
    if (within < 64) {
#pragma unroll
      for (int g = 0; g < 4; ++g) *(uint2*)(Q + 8 * g) = make_uint2(pk2(v[4 * g] * MSC, v[4 * g + 1] * MSC), pk2(v[4 * g + 2] * MSC, v[4 * g + 3] * MSC));
    } else {
      const int pos = tok < NP ? (int)(tok & 4095u) : 2048 + (int)((tok - NP) & 15u);
#pragma unroll
      for (int g = 0; g < 2; ++g) {
        float o1[4], o2[4];
#pragma unroll
        for (int j = 0; j < 4; ++j) {
          float c, s; rope_cs(pos, 8 * g + 4 * hi + j, c, s);
          const float x1 = v[4 * g + j], x2 = v[4 * (g + 2) + j];
          o1[j] = (x1 * c - x2 * s) * MSC; o2[j] = (x2 * c + x1 * s) * MSC;
        }
        *(uint2*)(Q + 8 * g) = make_uint2(pk2(o1[0], o1[1]), pk2(o1[2], o1[3]));
        *(uint2*)(Q + 8 * (g + 2)) = make_uint2(pk2(o2[0], o2[1]), pk2(o2[2], o2[3]));
      }
    }
  }
};

struct EpiKV {
  const Params& P; int cache;
  template <bool SW>
  DI void run(int rowbase, int colbase, const f32x16 v, int r32, int hi) const {
    if (SW) {
      const u32 tok = (u32)rowbase + r32;
      u32 krow_; size_t base;
      if (cache) { krow_ = (tok >> 11) * T_S + (tok & 2047u); base = WS_KN_S; }
      else if (tok >= NP) { const u32 ot = tok - NP; krow_ = (ot >> 4) * T_S + 2048u + (ot & 15u); base = WS_KN_S; }
      else { krow_ = tok; base = WS_KN_P; }
      u16* Kp = (u16*)(P.ws + base) + krow_ * 512u + colbase + 4 * hi;
#pragma unroll
      for (int g = 0; g < 4; ++g) *(uint2*)(Kp + 8 * g) = make_uint2(pk2(v[4 * g], v[4 * g + 1]), pk2(v[4 * g + 2], v[4 * g + 3]));
    } else {
      const u32 c = (u32)(colbase - 512) + r32;
      const u32 rb = (u32)rowbase + 4u * hi;
#pragma unroll
      for (int g = 0; g < 4; ++g) {
        const u32 row0 = rb + 8 * g;
        u32 bb, t0, T; size_t base;
        if (cache) { bb = row0 >> 11; t0 = row0 & 2047u; T = T_S; base = WS_VM_S; }
        else if (row0 >= NP) { const u32 ot = row0 - NP; bb = ot >> 4; t0 = 2048u + (ot & 15u); T = T_S; base = WS_VM_S; }
        else { bb = row0 >> 12; t0 = row0 & 4095u; T = 4096; base = WS_VM_P; }
        *(uint2*)((u16*)(P.ws + base) + ((bb * 512u + c) * T + t0)) = make_uint2(pk2(v[4 * g], v[4 * g + 1]), pk2(v[4 * g + 2], v[4 * g + 3]));
      }
    }
  }
};

struct EpiY {
  const Bufs& B;
  template <bool SW>
  DI void run(int rowbase, int colbase, const f32x16 v, int r32, int hi) const {
    u16* Yp = B.Y + ((u32)rowbase + r32) * 1024u + colbase + 4 * hi;
#pragma unroll
    for (int g = 0; g < 4; ++g) *(uint2*)(Yp + 8 * g) = make_uint2(pk2(v[4 * g], v[4 * g + 1]), pk2(v[4 * g + 2], v[4 * g + 3]));
  }
};

template <class Epi>
DI void phase_gemm(const u16* A, int lda, const u16* Bt, int ldb, int K, int ntn, char* lds, const Epi& epi, bool vsplit) {
  const int x = blockIdx.x & 7, j = blockIdx.x >> 3, nb = gridDim.x >> 3;
  if (ntn == 24) {
    const int nmt = (x >> 2) ? 129 : 128;
    for (int q = j; q < nmt * 6; q += nb) {
      const int ml = q / 6, nl = q - ml * 6;
      const int mt = (x >> 2) * 128 + ml, nt = (x & 3) * 6 + nl;
      if (vsplit && ((nt & 6) == 4) && nt < 16) gemm_tile<Epi, false>(A, lda, Bt, ldb, K, mt * 128, nt * 128, lds, epi);
      else gemm_tile<Epi, true>(A, lda, Bt, ldb, K, mt * 128, nt * 128, lds, epi);
    }
  } else {
    const int nmt = (x == 0) ? 33 : 32;
    for (int q = j; q < nmt * ntn; q += nb) {
      const int ml = q / ntn, nl = q - ml * ntn;
      const int mt = (ml < 32) ? x * 32 + ml : 256;
      gemm_tile<Epi, true>(A, lda, Bt, ldb, K, mt * 128, nl * 128, lds, epi);
    }
  }
}

DI void phase_A2b(const Params& P, const Bufs& B, int l, char* lds) {
  constexpr int NQ = (R / 128) * 6, NKV = (R / 128) * 8, NKC = 128 * 8;
  const EpiQ eq{B}; const EpiKV ekv{P, 0}; const EpiKV ekc{P, 1};
  const u16* wq = B.wq + (size_t)l * 768 * 256; const u16* wkv = B.wkv + (size_t)l * 1024 * 128;
  for (int t = blockIdx.x; t < NQ + NKV + NKC; t += gridDim.x) {
    if (t < NQ) { const int mt = t / 6, nt = t - mt * 6; gemm_tile<EpiQ, true>(B.CQN, 256, wq, 256, 256, mt * 128, nt * 128, lds, eq); }
    else if (t < NQ + NKV) {
      const int u = t - NQ; const int mt = u >> 3, nt = u & 7;
      if (nt < 4) gemm_tile<EpiKV, true>(B.CKVN, 128, wkv, 128, 128, mt * 128, nt * 128, lds, ekv);
      else gemm_tile<EpiKV, false>(B.CKVN, 128, wkv, 128, 128, mt * 128, nt * 128, lds, ekv);
    } else {
      const int u = t - NQ - NKV; const int mt = u >> 3, nt = u & 7;
      if (nt < 4) gemm_tile<EpiKV, true>(B.CKVC, 128, wkv, 128, 128, mt * 128, nt * 128, lds, ekc);
      else gemm_tile<EpiKV, false>(B.CKVC, 128, wkv, 128, 128, mt * 128, nt * 128, lds, ekc);
    }
  }
}

DI void phase_A2a(const Params& P, const Bufs& B, int l, char* lds) {
  const int tid = otid(), lane = tid & 63, w = tid >> 6;
  if (blockIdx.x < 16) {
    const int itb = blockIdx.x; const bool sp = itb >= 8; const int b = itb & 7;
    const int per = sp ? 9 : 16, total = sp ? 2064 : 4096, TT = sp ? T_S : 4096;
    const float4* c4 = (const float4*)(P.cache_fox_logf + ((size_t)l * 8 + b) * 2048 * 4);
    const float4* n4 = (const float4*)(B.LOGF + (sp ? ((size_t)NP + b * 16) * 4 : (size_t)b * 4096 * 4));
    const float4 zz = {0.f, 0.f, 0.f, 0.f};
    float4 v0 = zz, v1 = zz, v2 = zz, v3 = zz, v4 = zz, v5 = zz, v6 = zz, v7 = zz, v8 = zz, v9 = zz, v10 = zz, v11 = zz, v12 = zz, v13 = zz, v14 = zz, v15 = zz;
    double s0 = 0, s1 = 0, s2 = 0, s3 = 0;
#define FLD(i) if (i < per) { const int t = tid * per + i; if (t < total) v##i = sp ? (t < 2048 ? c4[t] : n4[t - 2048]) : n4[t]; s0 += v##i.x; s1 += v##i.y; s2 += v##i.z; s3 += v##i.w; }
    FLD(0) FLD(1) FLD(2) FLD(3) FLD(4) FLD(5) FLD(6) FLD(7) FLD(8) FLD(9) FLD(10) FLD(11) FLD(12) FLD(13) FLD(14) FLD(15)
#undef FLD
    double e0 = s0, e1 = s1, e2 = s2, e3 = s3;
#pragma unroll
    for (int o = 1; o < 64; o <<= 1) {
      const double t0 = shfl_up_d(e0, o), t1 = shfl_up_d(e1, o), t2 = shfl_up_d(e2, o), t3 = shfl_up_d(e3, o);
      if (lane >= o) { e0 += t0; e1 += t1; e2 += t2; e3 += t3; }
    }
    double* wt = (double*)lds;
    __syncthreads();
    if (lane == 63) { wt[w * 4 + 0] = e0; wt[w * 4 + 1] = e1; wt[w * 4 + 2] = e2; wt[w * 4 + 3] = e3; }
    __syncthreads();
    double r0 = e0 - s0, r1 = e1 - s1, r2 = e2 - s2, r3 = e3 - s3;
    for (int q = 0; q < w; ++q) { r0 += wt[q * 4 + 0]; r1 += wt[q * 4 + 1]; r2 += wt[q * 4 + 2]; r3 += wt[q * 4 + 3]; }
    float* d0 = (float*)(P.ws + (sp ? WS_FS : WS_FP)) + (size_t)b * 4 * TT;
#define FST(i) if (i < per) { const int t = tid * per + i; r0 += v##i.x; r1 += v##i.y; r2 += v##i.z; r3 += v##i.w; \
      if (t < TT) { d0[t] = (float)(r0 * (double)LOG2E); d0[TT + t] = (float)(r1 * (double)LOG2E); d0[2 * TT + t] = (float)(r2 * (double)LOG2E); d0[3 * TT + t] = (float)(r3 * (double)LOG2E); } }
    FST(0) FST(1) FST(2) FST(3) FST(4) FST(5) FST(6) FST(7) FST(8) FST(9) FST(10) FST(11) FST(12) FST(13) FST(14) FST(15)
#undef FST
    __syncthreads();
  }
  for (int g = blockIdx.x * 4 + w; g < R / 4; g += gridDim.x * 4) {
    const int row0 = g * 4;
    const bool samp = row0 >= NP;
    const int orow0 = samp ? row0 - NP : row0;
    const int bb = samp ? (orow0 >> 4) : (row0 >> 12);
    const int t0 = samp ? 2048 + (orow0 & 15) : (row0 & 4095);
    const int T = samp ? T_S : 4096;
    const size_t km0 = samp ? (size_t)bb * T_S + t0 : (size_t)row0;
    u16* KPE = (u16*)(P.ws + (samp ? WS_KPE_S : WS_KPE_P));
    const float4 gq = ((const float4*)(P.g_q_a + l * 256))[lane];
#pragma unroll
    for (int j = 0; j < 4; ++j) {
      const float4 v = *(const float4*)(B.TMP32 + (size_t)(row0 + j) * 416 + lane * 4);
      const float ss = wave_sum(v.x * v.x + v.y * v.y + v.z * v.z + v.w * v.w);
      const float rs = rsqrtf(ss * (1.f / 256.f) + EPSN);
      uint2 o = {pk2(v.x * rs * gq.x, v.y * rs * gq.y), pk2(v.z * rs * gq.z, v.w * rs * gq.w)};
      *(uint2*)(B.CQN + (size_t)(row0 + j) * 256 + lane * 4) = o;
    }
    const float2 gk = ((const float2*)(P.g_kv_a + l * 128))[lane];
    float* ockv = P.out + (samp ? O_SCKV + (size_t)l * 16384 : O_PCKV + (size_t)l * 4194304);
    float n0[4], n1[4];
#pragma unroll
    for (int j = 0; j < 4; ++j) {
      const float2 v = *(const float2*)(B.TMP32 + (size_t)(row0 + j) * 416 + 256 + lane * 2);
      const float ss = wave_sum(v.x * v.x + v.y * v.y);
      const float rs = rsqrtf(ss * (1.f / 128.f) + EPSN);
      n0[j] = v.x * rs * gk.x; n1[j] = v.y * rs * gk.y;
      float2 o = {n0[j], n1[j]};
      *(float2*)(ockv + (size_t)(orow0 + j) * 128 + lane * 2) = o;
      *(u32*)(B.CKVN + (size_t)(row0 + j) * 128 + lane * 2) = pk2(n0[j], n1[j]);
    }
    {
      const int j = lane >> 4, i = lane & 15;
      const float x1 = B.TMP32[(size_t)(row0 + j) * 416 + 384 + i], x2 = B.TMP32[(size_t)(row0 + j) * 416 + 400 + i];
      float c, s; rope_cs(t0 + j, i, c, s);
      const float o1 = x1 * c - x2 * s, o2 = x2 * c + x1 * s;
      float* okpe = P.out + (samp ? O_SKPE + (size_t)l * 4096 : O_PKPE + (size_t)l * 1048576);
      okpe[(size_t)(orow0 + j) * 32 + i] = o1; okpe[(size_t)(orow0 + j) * 32 + 16 + i] = o2;
      KPE[(km0 + j) * 32 + i] = bf1(o1); KPE[(km0 + j) * 32 + 16 + i] = bf1(o2);
    }
  }
  const size_t gtid = (size_t)blockIdx.x * 256 + tid, gsz = (size_t)gridDim.x * 256;
  for (size_t i = gtid; i < (size_t)2 * 8 * 2048 * 32; i += gsz) {
    const int which = (int)(i >> 19); const size_t r = i & 524287; const int cc = (int)(r & 31); const int bt = (int)(r >> 5);
    const int b = bt >> 11, t = bt & 2047;
    const float* src = (which ? P.cache_sb_k : P.cache_fox_k) + (((size_t)l * 8 + b) * 2048 + t) * 256 + cc * 8;
    const float4 v0 = ((const float4*)src)[0], v1 = ((const float4*)src)[1];
    uint4 o = {pk2(v0.x, v0.y), pk2(v0.z, v0.w), pk2(v1.x, v1.y), pk2(v1.z, v1.w)};
    *(uint4*)((u16*)(P.ws + (which ? WS_KS_S : WS_KF_S)) + ((size_t)b * T_S + t) * 256 + cc * 8) = o;
  }
  for (size_t i = gtid; i < (size_t)8 * 2048 * 20; i += gsz) {
    const int cc = (int)(i % 20); const int bt = (int)(i / 20); const int b = bt >> 11, t = bt & 2047;
    const float* srcp = cc < 16 ? P.cache_ckv + (((size_t)l * 8 + b) * 2048 + t) * 128 + cc * 8 : P.cache_kpe + (((size_t)l * 8 + b) * 2048 + t) * 32 + (cc - 16) * 8;
    const float4 v0 = ((const float4*)srcp)[0], v1 = ((const float4*)srcp)[1];
    uint4 o = {pk2(v0.x, v0.y), pk2(v0.z, v0.w), pk2(v1.x, v1.y), pk2(v1.z, v1.w)};
    if (cc < 16) *(uint4*)(B.CKVC + (size_t)bt * 128 + cc * 8) = o;
    else *(uint4*)(B.KPE_S + ((size_t)b * T_S + t) * 32 + (cc - 16) * 8) = o;
  }
  for (size_t i = gtid; i < (size_t)2 * 8 * 256 * 256; i += gsz) {
    const int which = (int)(i >> 19); const size_t r = i & 524287; const int hd = (int)(r & 255); const int t8 = (int)((r >> 8) & 255); const int b = (int)(r >> 16);
    const float* src = (which ? P.cache_sb_v : P.cache_fox_v) + (((size_t)l * 8 + b) * 2048 + t8 * 8) * 256 + hd;
    float v[8];
#pragma unroll
    for (int j = 0; j < 8; ++j) v[j] = src[(size_t)j * 256];
    uint4 o = {pk2(v[0], v[1]), pk2(v[2], v[3]), pk2(v[4], v[5]), pk2(v[6], v[7])};
    *(uint4*)((u16*)(P.ws + (which ? WS_VST_S : WS_VFT_S)) + ((size_t)b * 256 + hd) * T_S + t8 * 8) = o;
  }
  const uint4 z4 = {0u, 0u, 0u, 0u};
  for (size_t i = gtid; i < (size_t)8 * 48 * 32; i += gsz) {
    const int cc = (int)(i & 31); const int r = (int)((i >> 5) % 48); const int b = (int)(i / (48 * 32));
    *(uint4*)(B.KF_S + ((size_t)b * T_S + 2064 + r) * 256 + cc * 8) = z4;
    *(uint4*)(B.KS_S + ((size_t)b * T_S + 2064 + r) * 256 + cc * 8) = z4;
  }
  for (size_t i = gtid; i < (size_t)8 * 48 * 68; i += gsz) {
    const int cc = (int)(i % 68); const int r = (int)((i / 68) % 48); const int b = (int)(i / (48 * 68));
    if (cc < 64) *(uint4*)(B.KN_S + ((size_t)b * T_S + 2064 + r) * 512 + cc * 8) = z4;
    else *(uint4*)(B.KPE_S + ((size_t)b * T_S + 2064 + r) * 32 + (cc - 64) * 8) = z4;
  }
  for (size_t i = gtid; i < (size_t)8 * 512 * 6; i += gsz) {
    const int cc = (int)(i % 6); const int rr = (int)(i / 6);
    *(uint4*)(B.VM_S + (size_t)rr * T_S + 2064 + cc * 8) = z4;
    if (rr < 8 * 256) { *(uint4*)(B.VFT_S + (size_t)rr * T_S + 2064 + cc * 8) = z4; *(uint4*)(B.VST_S + (size_t)rr * T_S + 2064 + cc * 8) = z4; }
  }
}

typedef short v4i16_t __attribute__((ext_vector_type(4)));
DI uint2 lds_tr16(const u16* p) {
  const v4i16_t r = __builtin_amdgcn_ds_read_tr16_b64_v4i16((LAS v4i16_t*)(unsigned)(uintptr_t)p);
  return __builtin_bit_cast(uint2, r);
}
template <int TYPE>
DI void attn_item(const Params& P, const Bufs& B, int l, bool samp, int b, int hh, int qt, char* lds) {
  constexpr int DK = (TYPE == 2) ? 96 : 64, DV = 64;
  constexpr int KP = DK + 8, VP = 68;
  constexpr int NKC = 64 * DK / 8 / 256;
  constexpr int NVC = 2;
  constexpr int NDT = DV / 32;
  constexpr int NST = DK / 16;
  constexpr int STG = 64 * KP * 2 + 64 * VP * 2 + 256;
  const int tid = otid(), lane = tid & 63, w = __builtin_amdgcn_readfirstlane(tid >> 6), r32 = lane & 31, hi = lane >> 5;
  int head, qrow0, nvalid, qpos0, ntiles; bool active;
  if (!samp) { head = hh; qrow0 = b * 4096 + qt * 128 + w * 32; nvalid = 32; qpos0 = qt * 128 + w * 32; ntiles = 2 * qt + 2; active = true; }
  else {
    head = hh; active = (w == 0);
    qrow0 = NP + b * 16; nvalid = 16; qpos0 = 2048; ntiles = 33;
  }
  const int qi = r32 < nvalid ? r32 : nvalid - 1;
  const int qrow = qrow0 + qi, qpos = qpos0 + qi;
  const bool lane_valid = active && (r32 < nvalid);
  const int qlast = qpos0 + nvalid - 1;
  const int klim = samp ? 2064 : ((qpos0 >> 6) + 1) * 64;
  const u16* Kg; const u16* Kg2 = nullptr; const u16* Vg = nullptr; int kpitch, vpitch; const float* Fg = nullptr;
  {
    const int TT = samp ? T_S : 4096;
    vpitch = TT;
    if (TYPE == 2) {
      kpitch = 512;
      Kg = (const u16*)(P.ws + (samp ? WS_KN_S : WS_KN_P)) + (size_t)b * TT * 512 + head * 64;
      Kg2 = (const u16*)(P.ws + (samp ? WS_KPE_S : WS_KPE_P)) + (size_t)b * TT * 32;
      Vg = (const u16*)(P.ws + (samp ? WS_VM_S : WS_VM_P)) + ((size_t)(b * 8 + head) * 64) * TT;
    } else {
      kpitch = 256;
      Kg = (const u16*)(P.ws + (TYPE == 0 ? (samp ? WS_KF_S : WS_KF_P) : (samp ? WS_KS_S : WS_KS_P))) + (size_t)b * TT * 256 + head * 64;
      Vg = (const u16*)(P.ws + (TYPE == 0 ? (samp ? WS_VFT_S : WS_VFT_P) : (samp ? WS_VST_S : WS_VST_P))) + ((size_t)(b * 4 + head) * 64) * TT;
      Fg = (const float*)(P.ws + (samp ? WS_FS : WS_FP)) + (size_t)(b * 4 + head) * TT;
    }
  }
  const bf16x8 zb = {0, 0, 0, 0, 0, 0, 0, 0};
  bf16x8 qf0 = zb, qf1 = zb, qf2 = zb, qf3 = zb, qf4 = zb, qf5 = zb, qf6 = zb, qf7 = zb, qf8 = zb, qf9 = zb;
  {
    const u16* Qp = TYPE == 0 ? B.QF + (size_t)qrow * 256 + head * 64 : TYPE == 1 ? B.QS + (size_t)qrow * 256 + head * 64 : B.QM + (size_t)qrow * 768 + head * 96;
#define QLD(s) if (s < NST) qf##s = *(const bf16x8*)(Qp + s * 16 + hi * 8);
    QLD(0) QLD(1) QLD(2) QLD(3) QLD(4) QLD(5) QLD(6) QLD(7) QLD(8) QLD(9)
#undef QLD
  }
  float zmax = INFINITY;
  if (TYPE == 0 && !samp) {
    const float4 km = *(const float4*)((const float*)(P.ws + WS_KMAX) + ((l * 8 + b) * 4 + head) * 4);
    float qn = 0.f;
#define QSQ(s) _Pragma("unroll") for (int j = 0; j < 8; ++j) { const float x = __uint_as_float(((u32)(u16)qf##s[j]) << 16); qn += x * x; }
    QSQ(0) QSQ(1) QSQ(2) QSQ(3)
#undef QSQ
    qn = halves_sum(qn);
    zmax = sqrtf(qn * (km.x + km.y + km.z + km.w)) * 1.02f + 1e-3f;
  }
  f32x16 zf;
#pragma unroll
  for (int i = 0; i < 16; ++i) zf[i] = 0.f;
  f32x16 O0 = zf, O1 = zf, O2 = zf, O3 = zf;
  float m = -INFINITY, lsum = 0.f, carry = 1.f;
  bool wdead = !active;
  volatile int* dflags = (volatile int*)(lds + 2 * STG);
  const uint4 z4 = {0u, 0u, 0u, 0u};
  uint4 rak0 = z4, rak1 = z4, rak2 = z4, rav0 = z4, rav1 = z4; float raf_ = 0.f;
  uint4 rbk0 = z4, rbk1 = z4, rbk2 = z4, rbv0 = z4, rbv1 = z4; float rbf_ = 0.f;
#define KLD(S, i) if (i < NKC) { const int c_ = tid + 256 * i; const int row_ = (DK == 64) ? (c_ >> 3) : (c_ / 12); const int cc_ = (DK == 64) ? (c_ & 7) : (c_ - row_ * 12); \
    S##k##i = (DK == 64 || cc_ < 8) ? *(const uint4*)(Kg + (size_t)(k0_ + row_) * kpitch + cc_ * 8) : *(const uint4*)(Kg2 + (size_t)(k0_ + row_) * 32 + (cc_ - 8) * 8); }
#define VLD(S, i) { const int c_ = tid + 256 * i; S##v##i = *(const uint4*)(Vg + (size_t)(c_ >> 3) * vpitch + k0_ + (c_ & 7) * 8); }
#define ATT_PREFETCH(S, it_) { const int k0_ = ((TYPE != 2) ? ntiles - 1 - (it_) : (it_)) * 64; KLD(S, 0) KLD(S, 1) KLD(S, 2) VLD(S, 0) VLD(S, 1) if (TYPE == 0 && tid < 64) S##f_ = Fg[k0_ + tid]; }
#define KST(S, i) if (i < NKC) { const int c_ = tid + 256 * i; const int row_ = (DK == 64) ? (c_ >> 3) : (c_ / 12); const int cc_ = (DK == 64) ? (c_ & 7) : (c_ - row_ * 12); *(uint4*)(KsW + row_ * KP + cc_ * 8) = S##k##i; }
#define VST(S, i) { const int c_ = tid + 256 * i; u16* vd_ = VsW + (c_ >> 3) * VP + (c_ & 7) * 8; *(uint2*)vd_ = make_uint2(S##v##i.x, S##v##i.y); *(uint2*)(vd_ + 4) = make_uint2(S##v##i.z, S##v##i.w); }
#define ATT_STORE(S, st_) { u16* KsW = (u16*)(lds + (st_) * STG); u16* VsW = KsW + 64 * KP; float* FsW = (float*)(VsW + 64 * VP); \
    KST(S, 0) KST(S, 1) KST(S, 2) VST(S, 0) VST(S, 1) if (TYPE == 0 && tid < 64) FsW[tid] = S##f_; }
  auto tile_compute = [&](const int cur, const int it) __attribute__((always_inline)) {
    const int k0 = ((TYPE != 2) ? ntiles - 1 - it : it) * 64;
    const u16* Ks = (const u16*)(lds + cur * STG); const u16* Vs = Ks + 64 * KP; const float* Fs = (const float*)(Vs + 64 * VP);
    if (TYPE == 0 && !wdead) {
      const float bound = zmax - Fs[63];
      wdead = !__any(bound - m > -130.f);
    }
    const bool doit = active && (TYPE == 0 ? (!wdead && k0 <= qlast) : TYPE == 1 ? (!wdead && k0 < qlast) : (k0 < klim));
    if (doit) {
      f32x16 S0 = zf, S1 = zf;
      bool allzero = false;
#define SBAR __builtin_amdgcn_sched_barrier(0);
#define RD(s) bf16x8 ka##s = zb, kb##s = zb, qq##s = qf##s; if (s < NST) { ka##s = *(const bf16x8*)(Ks + r32 * KP + s * 16 + hi * 8); kb##s = *(const bf16x8*)(Ks + (32 + r32) * KP + s * 16 + hi * 8); \
                }
#define MM(s) if (s < NST) { S0 = MFMA(ka##s, qq##s, S0); S1 = MFMA(kb##s, qq##s, S1); }
      RD(0) RD(1) SBAR RD(2) SBAR MM(0) SBAR RD(3) SBAR MM(1) SBAR RD(4) SBAR MM(2) SBAR RD(5) SBAR MM(3) SBAR RD(6) SBAR MM(4) SBAR
      RD(7) SBAR MM(5) SBAR RD(8) SBAR MM(6) SBAR RD(9) SBAR MM(7) SBAR MM(8) SBAR MM(9) SBAR
#undef RD
#undef MM
      if (TYPE == 1) {
        f32x16 R0, R1;
        const bool need_mask = (k0 + 63 >= qpos0);
#pragma unroll
        for (int i = 0; i < 16; ++i) {
          const float e0 = ex2(fminf(S0[i], 60.f)), e1 = ex2(fminf(S1[i], 60.f));
          const float r0 = __builtin_amdgcn_rcpf(1.f + e0), r1 = __builtin_amdgcn_rcpf(1.f + e1);
          R0[i] = r0; R1[i] = r1; S0[i] = e0 * r0; S1[i] = e1 * r1;
        }
        if (need_mask) {
#pragma unroll
          for (int i = 0; i < 16; ++i) {
            const int key = k0 + crow(i, hi);
            if (!(key < qpos)) { R0[i] = 1.f; S0[i] = 0.f; }
            if (!(key + 32 < qpos)) { R1[i] = 1.f; S1[i] = 0.f; }
          }
        }
        float Rr = carry;
#define SBG(RV, SV, g) { \
          const float gown = (RV[4 * g] * RV[4 * g + 1]) * (RV[4 * g + 2] * RV[4 * g + 3]); \
          const float goth = __shfl_xor(gown, 32); \
          float sfx = hi ? Rr : Rr * goth; \
          SV[4 * g + 3] *= sfx; sfx *= RV[4 * g + 3]; \
          SV[4 * g + 2] *= sfx; sfx *= RV[4 * g + 2]; \
          SV[4 * g + 1] *= sfx; sfx *= RV[4 * g + 1]; \
          SV[4 * g] *= sfx; \
          Rr *= gown * goth; }
        SBG(R1, S1, 3) SBG(R1, S1, 2) SBG(R1, S1, 1) SBG(R1, S1, 0)
        SBG(R0, S0, 3) SBG(R0, S0, 2) SBG(R0, S0, 1) SBG(R0, S0, 0)
#undef SBG
        carry = Rr;
        wdead = !__any(carry != 0.f);
      } else {
        if (TYPE == 0) {
#pragma unroll
          for (int g = 0; g < 4; ++g) {
            const float4 f0 = *(const float4*)(Fs + 8 * g + 4 * hi);
            const float4 f1 = *(const float4*)(Fs + 32 + 8 * g + 4 * hi);
            S0[4 * g] -= f0.x; S0[4 * g + 1] -= f0.y; S0[4 * g + 2] -= f0.z; S0[4 * g + 3] -= f0.w;
            S1[4 * g] -= f1.x; S1[4 * g + 1] -= f1.y; S1[4 * g + 2] -= f1.z; S1[4 * g + 3] -= f1.w;
          }
          if (k0 + 63 > qpos0) {
#pragma unroll
            for (int i = 0; i < 16; ++i) {
              const int key = k0 + crow(i, hi);
              if (key > qpos) S0[i] = -INFINITY;
              if (key + 32 > qpos) S1[i] = -INFINITY;
            }
          }
        } else {
          if (k0 + 64 > klim) {
#pragma unroll
            for (int i = 0; i < 16; ++i) {
              const int key = k0 + crow(i, hi);
              if (key >= klim) S0[i] = -INFINITY;
              if (key + 32 >= klim) S1[i] = -INFINITY;
            }
          }
        }
        float mx = S0[0];
#pragma unroll
        for (int i = 1; i < 16; ++i) mx = fmaxf(mx, S0[i]);
#pragma unroll
        for (int i = 0; i < 16; ++i) mx = fmaxf(mx, S1[i]);
        mx = halves_max(mx);
        if (TYPE == 0) allzero = !__any(mx - m > -130.f);
        if (__any(mx > m + 8.f)) {
          const float mnew = fmaxf(m, mx);
          const float alpha = ex2(m - mnew);
          m = mnew;
          lsum *= alpha;
#pragma unroll
          for (int i = 0; i < 16; ++i) { O0[i] *= alpha; O1[i] *= alpha; if (NDT > 2) { O2[i] *= alpha; O3[i] *= alpha; } }
        }
        if (!allzero) {
          float ps = 0.f;
#pragma unroll
          for (int i = 0; i < 16; ++i) { S0[i] = ex2(S0[i] - m); S1[i] = ex2(S1[i] - m); ps += S0[i] + S1[i]; }
          lsum += ps;
        }
      }
      if (!allzero) {
      const bf16x8 pf0 = __builtin_bit_cast(bf16x8, make_uint4(pk2(S0[0], S0[1]), pk2(S0[2], S0[3]), pk2(S0[4], S0[5]), pk2(S0[6], S0[7])));
      const bf16x8 pf1 = __builtin_bit_cast(bf16x8, make_uint4(pk2(S0[8], S0[9]), pk2(S0[10], S0[11]), pk2(S0[12], S0[13]), pk2(S0[14], S0[15])));
      const bf16x8 pf2 = __builtin_bit_cast(bf16x8, make_uint4(pk2(S1[0], S1[1]), pk2(S1[2], S1[3]), pk2(S1[4], S1[5]), pk2(S1[6], S1[7])));
      const bf16x8 pf3 = __builtin_bit_cast(bf16x8, make_uint4(pk2(S1[8], S1[9]), pk2(S1[10], S1[11]), pk2(S1[12], S1[13]), pk2(S1[14], S1[15])));
      const u16* vbase = Vs + r32 * VP + 4 * hi;
#define VRD(d, sp) bf16x8 vf##d##sp = zb; if (d < NDT) { const uint2 lo = *(const uint2*)(vbase + d * 32 * VP + 16 * sp); const uint2 h8 = *(const uint2*)(vbase + d * 32 * VP + 16 * sp + 8); \
        vf##d##sp = __builtin_bit_cast(bf16x8, make_uint4(lo.x, lo.y, h8.x, h8.y)); }
#define VMM(d, sp) if (d < NDT) { O##d = MFMA(vf##d##sp, pf##sp, O##d); }
      VRD(0, 0) VRD(1, 0) VRD(0, 1) SBAR VRD(1, 1) SBAR VMM(0, 0) SBAR VRD(0, 2) SBAR VMM(1, 0) SBAR VRD(1, 2) SBAR VMM(0, 1) SBAR VRD(0, 3) SBAR VMM(1, 1) SBAR VRD(1, 3) SBAR
      VMM(0, 2) SBAR VRD(2, 0) SBAR VMM(1, 2) SBAR VRD(3, 0) SBAR VMM(0, 3) SBAR VRD(2, 1) SBAR VMM(1, 3) SBAR VRD(3, 1) SBAR
      VMM(2, 0) SBAR VRD(2, 2) SBAR VMM(3, 0) SBAR VRD(3, 2) SBAR VMM(2, 1) SBAR VRD(2, 3) SBAR VMM(3, 1) SBAR VRD(3, 3) SBAR
      VMM(2, 2) SBAR VMM(3, 2) SBAR VMM(2, 3) SBAR VMM(3, 3) SBAR
#undef VRD
#undef VMM
#undef SBAR
      }
    }
  };
  ATT_PREFETCH(ra, 0)
  if (ntiles > 1) { ATT_PREFETCH(rb, 1) }
  ATT_STORE(ra, 0)
  __syncthreads();
  for (int it = 0; it < ntiles; it += 2) {
    if (it + 2 < ntiles) { ATT_PREFETCH(ra, it + 2) }
    __builtin_amdgcn_sched_barrier(0);
    tile_compute(0, it);
    if (it + 1 < ntiles) { ATT_STORE(rb, 1) }
    if (TYPE != 2 && lane == 0) dflags[w] = wdead ? 1 : 0;
    __syncthreads();
    if (TYPE != 2) { if (dflags[0] & dflags[1] & dflags[2] & dflags[3]) break; }
    if (it + 1 >= ntiles) break;
    if (it + 3 < ntiles) { ATT_PREFETCH(rb, it + 3) }
    __builtin_amdgcn_sched_barrier(0);
    tile_compute(1, it + 1);
    if (it + 2 < ntiles) { ATT_STORE(ra, 0) }
    if (TYPE != 2 && lane == 0) dflags[4 + w] = wdead ? 1 : 0;
    __syncthreads();
    if (TYPE != 2) { if (dflags[4] & dflags[5] & dflags[6] & dflags[7]) break; }
  }
#undef ATT_PREFETCH
#undef ATT_STORE
#undef KLD
#undef VLD
#undef KST
#undef VST
  if (active) {
    float inv = 1.f;
    if (TYPE != 1) { const float lt = halves_sum(lsum); inv = 1.f / lt; }
    const u32 orow = (u32)qrow * 1024u;
    {
      const int goff = (TYPE == 0 ? 0 : TYPE == 1 ? 256 : 512) + head * 64;
#define OEP(d) _Pragma("unroll") for (int g = 0; g < 4; ++g) { \
          const int dd = d * 32 + 8 * g + 4 * hi; \
          const uint2 gv = *(const uint2*)(B.GATE + orow + goff + dd); \
          const float g0 = __uint_as_float(gv.x << 16), g1 = __uint_as_float(gv.x & 0xffff0000u), g2 = __uint_as_float(gv.y << 16), g3 = __uint_as_float(gv.y & 0xffff0000u); \
          uint2 o = {pk2(O##d[4 * g] * inv * g0, O##d[4 * g + 1] * inv * g1), pk2(O##d[4 * g + 2] * inv * g2, O##d[4 * g + 3] * inv * g3)}; \
          if (lane_valid) *(uint2*)(B.H + orow + goff + dd) = o; }
      OEP(0) OEP(1)
#undef OEP
    }
  }
}

constexpr int N_Q_ITEMS = 16 + 512;
DI void phase_attn(const Params& P, const Bufs& B, int ci, int l, char* lds, int* s_item, int xcc, int only_type = -1) {
  for (int qx = 0; qx < 8; ++qx) {
    const int q = (xcc + qx) & 7;
    while (true) {
      __syncthreads();
      if (threadIdx.x == 0) *s_item = (int)atomicAdd(B.ctr + ci * 8 + q, 1u);
      __syncthreads();
      const int it = *s_item;
      if (it >= N_Q_ITEMS) break;
      bool samp; int type, hh, qt; const int b = q;
      if (it < 16) {
        samp = true; qt = 0;
        if (it < 8) { type = 2; hh = it; } else if (it < 12) { type = 0; hh = it - 8; } else { type = 1; hh = it - 12; }
      } else {
        const int j = it - 16;
        samp = false;
        qt = 31 - (j >> 4); const int k16 = j & 15;
        if (k16 & 1) { type = 2; hh = k16 >> 1; } else if (k16 & 2) { type = 0; hh = k16 >> 2; } else { type = 1; hh = k16 >> 2; }
      }
      if (only_type >= 0 && type != only_type) continue;
      if (type == 0) attn_item<0>(P, B, l, samp, b, hh, qt, lds);
      else if (type == 1) attn_item<1>(P, B, l, samp, b, hh, qt, lds);
      else attn_item<2>(P, B, l, samp, b, hh, qt, lds);
    }
  }
}

__global__ void __launch_bounds__(256, 2) fwd_megakernel(Params P) {
  cg::grid_group grid = cg::this_grid();
  __shared__ __attribute__((aligned(16))) char lds[73728];
  __shared__ int s_item;
  __shared__ uint4 xb_words;
  if (threadIdx.x == 0) xb_words = make_uint4(0u, 0u, 0u, 0u);
  __syncthreads();
  const XcdBarrier xb = xcd_barrier_post((unsigned*)(P.ws + WS_BAR), (volatile LAS unsigned*)&xb_words);
  if (P.ws == nullptr) grid.sync();
  const Bufs B = make_bufs(P.ws);
  phase_prep(P, B);
  xcd_barrier(xb);
  phase_mod(P, B, lds);
  xcd_barrier(xb);
  phase_D(P, B, 0);
  xcd_barrier(xb);
#pragma unroll 1
  for (int l = 0; l < 2; ++l) {
#pragma unroll 1
    for (int rep = 0; rep <= REP_GEMM; ++rep) { EpiIn e{P, B, l}; phase_gemm(B.H, 1024, B.win + (size_t)l * 3072 * 1024, 1024, 1024, 24, lds, e, true); }
    xcd_barrier(xb);
    phase_A2a(P, B, l, lds);
    xcd_barrier(xb);
#pragma unroll 1
    for (int rep = 0; rep <= REP_GEMM; ++rep) phase_A2b(P, B, l, lds);
    xcd_barrier(xb);
#pragma unroll 1
    for (int rep = 0; rep <= REP_ATTN; ++rep) { phase_attn(P, B, l + 2 * rep, l, lds, &s_item, (int)xb.x, rep ? 2 : -1); if (rep < REP_ATTN) xcd_barrier(xb); }
    xcd_barrier(xb);
#pragma unroll 1
    for (int rep = 0; rep <= REP_GEMM; ++rep) { EpiY e{B}; phase_gemm(B.H, 1024, B.wout + (size_t)l * 1024 * 1024, 1024, 1024, 8, lds, e, false); }
    xcd_barrier(xb);
    phase_D(P, B, l + 1);
    if (l == 0) xcd_barrier(xb);
  }
}

extern "C" void kernel_launch(void* const* d_in, const int* in_sizes, int n_in,
                              void* d_out, int out_size, void* d_ws, size_t ws_size,
                              hipStream_t stream) {
  static int grid_blocks = 0;
  if (!grid_blocks) {
    int dev = 0, cus = 0, per_cu = 0;
    (void)hipGetDevice(&dev);
    (void)hipDeviceGetAttribute(&cus, hipDeviceAttributeMultiprocessorCount, dev);
    (void)hipOccupancyMaxActiveBlocksPerMultiprocessor(&per_cu, fwd_megakernel, 256, 0);
    if (per_cu > 2) per_cu = 2;
    if (per_cu < 1) per_cu = 1;
    grid_blocks = cus * per_cu;
    if (ws_size < WS_END) fprintf(stderr, "workspace too small: %zu < %zu\n", ws_size, (size_t)WS_END);
  }
  Params p{};
  const float** pp = (const float**)&p;
  for (int i = 0; i < 23; ++i) pp[i] = (const float*)d_in[i];
  p.out = (float*)d_out;
  p.ws = (unsigned char*)d_ws;
  (void)hipMemsetAsync((char*)d_ws + WS_CTR, 0, 256 + 16384, stream);
  void* args[] = {&p};
  hipError_t e = hipLaunchCooperativeKernel((void*)fwd_megakernel, dim3(grid_blocks), dim3(256), args, 0, stream);
  if (e != hipSuccess) fprintf(stderr, "cooperative launch failed: %s (grid %d)\n", hipGetErrorString(e), grid_blocks);
}
```

```cpp
#include <hip/hip_runtime.h>
#include <hip/hip_cooperative_groups.h>
#include <cstdio>
#include <cstdint>
namespace cg = cooperative_groups;
#define REP_ATTN 0
#define REP_GEMM 0

typedef unsigned short u16;
typedef unsigned int u32;
using bf16x8 = __attribute__((ext_vector_type(8))) short;
using f32x16 = __attribute__((ext_vector_type(16))) float;
typedef __bf16 bf16x2_t __attribute__((ext_vector_type(2)));
typedef float f32x2_t __attribute__((ext_vector_type(2)));
#define DI __device__ __forceinline__
#define MFMA(a, b, c) __builtin_amdgcn_mfma_f32_32x32x16_bf16((a), (b), (c), 0, 0, 0)

constexpr int NP = 32768, NSM = 128, R = NP + NSM;
constexpr int T_S = 2112;
constexpr float LOG2E = 1.4426950408889634f;
constexpr float QSC = 0.125f * LOG2E;
constexpr float MSC = 0.10206207261596575f * LOG2E;
constexpr float EPSN = 1e-6f;

constexpr size_t O_Y = 0;
constexpr size_t O_PFK = (size_t)R * 1024;
constexpr size_t O_PFV = O_PFK + 16777216;
constexpr size_t O_PLF = O_PFV + 16777216;
constexpr size_t O_PSK = O_PLF + 262144;
constexpr size_t O_PSV = O_PSK + 16777216;
constexpr size_t O_PCKV = O_PSV + 16777216;
constexpr size_t O_PKPE = O_PCKV + 8388608;
constexpr size_t O_SFK = O_PKPE + 2097152;
constexpr size_t O_SFV = O_SFK + 65536;
constexpr size_t O_SLF = O_SFV + 65536;
constexpr size_t O_SSK = O_SLF + 1024;
constexpr size_t O_SSV = O_SSK + 65536;
constexpr size_t O_SCKV = O_SSV + 65536;
constexpr size_t O_SKPE = O_SCKV + 32768;

constexpr size_t al256(size_t x) { return (x + 255) & ~(size_t)255; }
constexpr size_t WS_CTR = 0;
constexpr size_t WS_BAR = 256;
constexpr size_t WS_KMAX = 256 + 14336;
constexpr size_t WS_SILUC = 256 + 16384;
constexpr size_t WS_MOD = WS_SILUC + 16 * 1024 * 4;
constexpr size_t WS_WIN = WS_MOD + 2 * 16 * 3072 * 4;
constexpr size_t WS_WQ = WS_WIN + (size_t)2 * 3072 * 1024 * 2;
constexpr size_t WS_WKV = WS_WQ + (size_t)2 * 768 * 256 * 2;
constexpr size_t WS_WOUT = WS_WKV + (size_t)2 * 1024 * 128 * 2;
constexpr size_t WS_H = WS_WOUT + (size_t)2 * 1024 * 1024 * 2;
constexpr size_t WS_GATE = WS_H + (size_t)R * 1024 * 2;
constexpr size_t WS_QM = WS_GATE + (size_t)R * 1024 * 2;
constexpr size_t WS_TMP32 = WS_QM;
constexpr size_t WS_CQN = WS_QM + (size_t)R * 1024 * 2;
constexpr size_t WS_QF = WS_CQN + (size_t)R * 256 * 2;
constexpr size_t WS_QS = WS_QF + (size_t)R * 256 * 2;
constexpr size_t WS_KF_P = WS_QS + (size_t)R * 256 * 2;
constexpr size_t WS_KS_P = WS_KF_P + (size_t)NP * 256 * 2;
constexpr size_t WS_VFT_P = WS_KS_P + (size_t)NP * 256 * 2;
constexpr size_t WS_VST_P = WS_VFT_P + (size_t)NP * 256 * 2;
constexpr size_t WS_KN_P = WS_VST_P + (size_t)NP * 256 * 2;
constexpr size_t WS_KPE_P = WS_KN_P + (size_t)NP * 512 * 2;
constexpr size_t WS_VM_P = WS_KPE_P + (size_t)NP * 32 * 2;
constexpr size_t WS_CKVN = WS_VM_P + (size_t)NP * 512 * 2;
constexpr size_t WS_KF_S = WS_CKVN + (size_t)R * 128 * 2;
constexpr size_t WS_KS_S = WS_KF_S + (size_t)8 * T_S * 256 * 2;
constexpr size_t WS_VFT_S = WS_KS_S + (size_t)8 * T_S * 256 * 2;
constexpr size_t WS_VST_S = WS_VFT_S + (size_t)8 * T_S * 256 * 2;
constexpr size_t WS_KN_S = WS_VST_S + (size_t)8 * T_S * 256 * 2;
constexpr size_t WS_KPE_S = WS_KN_S + (size_t)8 * T_S * 512 * 2;
constexpr size_t WS_VM_S = WS_KPE_S + (size_t)8 * T_S * 32 * 2;
constexpr size_t WS_CKVC = WS_VM_S + (size_t)8 * T_S * 512 * 2;
constexpr size_t WS_LOGF = WS_CKVC + (size_t)8 * 2048 * 128 * 2;
constexpr size_t WS_FP = WS_LOGF + (size_t)R * 4 * 4;
constexpr size_t WS_FS = WS_FP + (size_t)8 * 4 * 4096 * 4;
constexpr size_t WS_END = WS_FS + (size_t)8 * 4 * T_S * 4;
static_assert((size_t)R * 416 * 4 <= (size_t)R * 1024 * 2 && (size_t)R * 768 * 2 <= (size_t)R * 1024 * 2, "aliases must fit");
static_assert(WS_END < (size_t)530 * 1000 * 1000, "workspace too large");

struct Params {
  const float* x_prompt; const float* x_sample; const float* c_prompt; const float* c_sample;
  const float* cache_fox_k; const float* cache_fox_v; const float* cache_fox_logf;
  const float* cache_sb_k; const float* cache_sb_v; const float* cache_ckv; const float* cache_kpe;
  const float* g_pre; const float* g_post; const float* w_ada; const float* b_ada; const float* w_in;
  const float* b_f; const float* g_q_a; const float* w_uq; const float* g_kv_a; const float* w_uk;
  const float* w_uv; const float* w_out;
  float* out;
  unsigned char* ws;
};

DI u32 pk2(float a, float b) { f32x2_t v = {a, b}; bf16x2_t r = __builtin_convertvector(v, bf16x2_t); return __builtin_bit_cast(u32, r); }
DI u16 bf1(float a) { return (u16)(pk2(a, 0.f) & 0xffffu); }
DI int crow(int i, int hi) { return (i & 3) + 8 * (i >> 2) + 4 * hi; }
DI float wave_sum(float v) {
#pragma unroll
  for (int o = 32; o > 0; o >>= 1) v += __shfl_xor(v, o);
  return v;
}
DI double shfl_up_d(double x, int o) { int lo = __double2loint(x), hi = __double2hiint(x); lo = __shfl_up(lo, o); hi = __shfl_up(hi, o); return __hiloint2double(hi, lo); }
DI int otid() { int t = threadIdx.x; asm volatile("" : "+v"(t)); return t; }
DI float ex2(float x) { return __builtin_amdgcn_exp2f(x); }
DI float lg2(float x) { return __builtin_amdgcn_logf(x); }
DI float silu_f(float v) { return v * __builtin_amdgcn_rcpf(1.f + __expf(-v)); }
DI float halves_sum(float x) { auto rr = __builtin_amdgcn_permlane32_swap(__float_as_uint(x), __float_as_uint(x), false, false); return __uint_as_float(rr[0]) + __uint_as_float(rr[1]); }
DI float halves_max(float x) { auto rr = __builtin_amdgcn_permlane32_swap(__float_as_uint(x), __float_as_uint(x), false, false); return fmaxf(__uint_as_float(rr[0]), __uint_as_float(rr[1])); }
DI void rope_cs(int pos, int fidx, float& c, float& s) {
  const float inv = ex2(-(float)fidx * (13.287712379549449f / 16.f));
  float rev = ((float)pos * inv) * 0.15915494309189535f;
  rev = rev - floorf(rev);
  s = __builtin_amdgcn_sinf(rev); c = __builtin_amdgcn_cosf(rev);
}

struct Bufs {
  u32* ctr; float* siluc; float* mod; u16* win; u16* wq; u16* wkv; u16* wout; u16* H; u16* GATE; u16* QM; u16* Y; float* TMP32;
  u16* CQN; u16* QF; u16* QS; u16* KF_P; u16* KS_P; u16* VFT_P; u16* VST_P; u16* KN_P; u16* KPE_P; u16* VM_P; u16* CKVN;
  u16* KF_S; u16* KS_S; u16* VFT_S; u16* VST_S; u16* KN_S; u16* KPE_S; u16* VM_S; u16* CKVC; float* LOGF; float* FP; float* FS;
};
DI Bufs make_bufs(unsigned char* ws) {
  Bufs B;
  B.ctr = (u32*)(ws + WS_CTR); B.siluc = (float*)(ws + WS_SILUC); B.mod = (float*)(ws + WS_MOD); B.win = (u16*)(ws + WS_WIN);
  B.wq = (u16*)(ws + WS_WQ); B.wkv = (u16*)(ws + WS_WKV); B.wout = (u16*)(ws + WS_WOUT); B.H = (u16*)(ws + WS_H); B.GATE = (u16*)(ws + WS_GATE);
  B.QM = (u16*)(ws + WS_QM); B.Y = (u16*)(ws + WS_QM); B.TMP32 = (float*)(ws + WS_TMP32); B.CQN = (u16*)(ws + WS_CQN);
  B.QF = (u16*)(ws + WS_QF); B.QS = (u16*)(ws + WS_QS); B.KF_P = (u16*)(ws + WS_KF_P); B.KS_P = (u16*)(ws + WS_KS_P);
  B.VFT_P = (u16*)(ws + WS_VFT_P); B.VST_P = (u16*)(ws + WS_VST_P); B.KN_P = (u16*)(ws + WS_KN_P); B.KPE_P = (u16*)(ws + WS_KPE_P); B.VM_P = (u16*)(ws + WS_VM_P); B.CKVN = (u16*)(ws + WS_CKVN);
  B.KF_S = (u16*)(ws + WS_KF_S); B.KS_S = (u16*)(ws + WS_KS_S); B.VFT_S = (u16*)(ws + WS_VFT_S); B.VST_S = (u16*)(ws + WS_VST_S);
  B.KN_S = (u16*)(ws + WS_KN_S); B.KPE_S = (u16*)(ws + WS_KPE_S); B.VM_S = (u16*)(ws + WS_VM_S); B.CKVC = (u16*)(ws + WS_CKVC); B.LOGF = (float*)(ws + WS_LOGF); B.FP = (float*)(ws + WS_FP); B.FS = (float*)(ws + WS_FS);
  return B;
}


#define XB_TMO      128
#define XB_XCNT(j)  (256  + 64 * (j))
#define XB_XSUB(j)  (1280 + 64 * (j))
#define XB_XGEN(j)  (2304 + 64 * (j))
#define XB_TOP      3328
#define XB_TOPGEN   3392
#define XCD_BAR_WORDS 3456
#define XB_SPIN_CAP (1u << 22)
#define LAS __attribute__((address_space(3)))
DI unsigned xb_ld(unsigned* p) { return __hip_atomic_load(p, __ATOMIC_RELAXED, __HIP_MEMORY_SCOPE_AGENT); }
DI unsigned xb_add(unsigned* p, unsigned v) { return __hip_atomic_fetch_add(p, v, __ATOMIC_RELAXED, __HIP_MEMORY_SCOPE_AGENT); }
DI unsigned xb_xcc_id() { return (unsigned)__builtin_amdgcn_s_getreg((3 << 11) | 20) & 0xFu; }
#define XB_SPIN(cond, bar) do { unsigned _sp = 0; while (cond) { __builtin_amdgcn_s_sleep(1); \
    if ((++_sp & 255u) == 0u) { if (xb_ld(&(bar)[XB_TMO])) break; if (_sp > XB_SPIN_CAP) { atomicAdd(&(bar)[XB_TMO], 1u); break; } } } } while (0)
struct XcdBarrier { unsigned* bar; unsigned x; volatile LAS unsigned* st; };
DI XcdBarrier xcd_barrier_post(unsigned* bar, volatile LAS unsigned* st) {
  XcdBarrier b; b.bar = bar; b.x = xb_xcc_id(); b.st = st;
  if (threadIdx.x == 0) (void)xb_add(&bar[XB_XCNT(b.x)], 1u);
  return b;
}
DI void xcd_barrier_complete(unsigned* bar, unsigned x, unsigned& nloc, unsigned& nx) {
  const unsigned G = gridDim.x * gridDim.y * gridDim.z;
  unsigned sum, cnt, mine, sp = 0u;
  for (;;) {
    sum = 0u; cnt = 0u; mine = 0u;
#pragma unroll
    for (unsigned j = 0; j < 16; ++j) { const unsigned c = xb_ld(&bar[XB_XCNT(j)]); sum += c; cnt += (c > 0u) ? 1u : 0u; mine = (j == x) ? c : mine; }
    if (sum == G) break;
    __builtin_amdgcn_s_sleep(1);
    if ((++sp & 255u) == 0u) { if (xb_ld(&bar[XB_TMO])) break; if (sp > XB_SPIN_CAP) { atomicAdd(&bar[XB_TMO], 1u); break; } }
  }
  nloc = mine > 0u ? mine : 1u; nx = cnt > 0u ? cnt : 1u;
}
DI void xcd_barrier(const XcdBarrier& b) {
  asm volatile("s_waitcnt vmcnt(0)" ::: "memory");
  __syncthreads();
  if (threadIdx.x == 0) {
    unsigned* bar = b.bar;
    __builtin_amdgcn_s_waitcnt(0);
    unsigned nloc = b.st[0], nx = b.st[1];
    if (nloc == 0u) { xcd_barrier_complete(bar, b.x, nloc, nx); b.st[0] = nloc; b.st[1] = nx; }
    const unsigned old = xb_add(&bar[XB_XSUB(b.x)], 1u);
    const unsigned gen = old / nloc;
    if (old + 1u == (gen + 1u) * nloc) {
      __builtin_amdgcn_fence(__ATOMIC_RELEASE, "agent");
      asm volatile("s_waitcnt vmcnt(0)" ::: "memory");
      const unsigned og = xb_add(&bar[XB_TOP], 1u);
      const unsigned tg = og / nx;
      if (og + 1u == (tg + 1u) * nx) xb_add(&bar[XB_TOPGEN], 1u);
      else XB_SPIN(xb_ld(&bar[XB_TOPGEN]) == tg, bar);
      __builtin_amdgcn_fence(__ATOMIC_ACQUIRE, "agent");
      xb_add(&bar[XB_XGEN(b.x)], 1u);
      asm volatile("s_waitcnt vmcnt(0)" ::: "memory");
    } else {
      XB_SPIN(xb_ld(&bar[XB_XGEN(b.x)]) == gen, bar);
      __builtin_amdgcn_fence(__ATOMIC_ACQUIRE, "agent");
      asm volatile("s_waitcnt vmcnt(0)" ::: "memory");
    }
  }
  __syncthreads();
}

DI int in_colmap(int n) { return n < 768 ? n : n < 2432 ? n + 4 : n < 2944 ? n + 36 : n < 2976 ? n - 508 : n < 2980 ? n - 2208 : -1; }

DI void phase_prep(const Params& P, const Bufs& B) {
  const size_t gtid = (size_t)blockIdx.x * 256 + otid(), gsz = (size_t)gridDim.x * 256;
  for (size_t i = gtid; i < 16 * 1024; i += gsz) {
    const float c = i < 8192 ? P.c_prompt[i] : P.c_sample[i - 8192];
    B.siluc[i] = c / (1.f + __expf(-c));
  }
  for (size_t i = gtid; i < (size_t)2 * 128 * 3072; i += gsz) {
    const int n = (int)(i % 3072); const int kc = (int)((i / 3072) % 128); const int l = (int)(i / (3072 * 128));
    const int col = in_colmap(n);
    float v[8];
#pragma unroll
    for (int j = 0; j < 8; ++j) v[j] = col >= 0 ? P.w_in[((size_t)l * 1024 + kc * 8 + j) * 2980 + col] : 0.f;
    uint4 o = {pk2(v[0], v[1]), pk2(v[2], v[3]), pk2(v[4], v[5]), pk2(v[6], v[7])};
    *(uint4*)(B.win + ((size_t)l * 3072 + n) * 1024 + kc * 8) = o;
  }
  for (size_t i = gtid; i < (size_t)2 * 128 * 1024; i += gsz) {
    const int n = (int)(i & 1023); const int kc = (int)((i >> 10) & 127); const int l = (int)(i >> 17);
    float v[8];
#pragma unroll
    for (int j = 0; j < 8; ++j) v[j] = P.w_out[((size_t)l * 1024 + kc * 8 + j) * 1024 + n];
    uint4 o = {pk2(v[0], v[1]), pk2(v[2], v[3]), pk2(v[4], v[5]), pk2(v[6], v[7])};
    *(uint4*)(B.wout + ((size_t)l * 1024 + n) * 1024 + kc * 8) = o;
  }
  for (size_t i = gtid; i < (size_t)2 * 32 * 768; i += gsz) {
    const int n = (int)(i % 768); const int kc = (int)((i / 768) & 31); const int l = (int)(i / (768 * 32));
    float v[8];
#pragma unroll
    for (int j = 0; j < 8; ++j) v[j] = P.w_uq[((size_t)l * 256 + kc * 8 + j) * 768 + n];
    uint4 o = {pk2(v[0], v[1]), pk2(v[2], v[3]), pk2(v[4], v[5]), pk2(v[6], v[7])};
    *(uint4*)(B.wq + ((size_t)l * 768 + n) * 256 + kc * 8) = o;
  }
  for (size_t i = gtid; i < (size_t)2 * 16 * 1024; i += gsz) {
    const int n = (int)(i & 1023); const int kc = (int)((i >> 10) & 15); const int l = (int)(i >> 14);
    const float* srcw = (n < 512 ? P.w_uk : P.w_uv) + (size_t)l * 128 * 512 + (n & 511);
    float v[8];
#pragma unroll
    for (int j = 0; j < 8; ++j) v[j] = srcw[(size_t)(kc * 8 + j) * 512];
    uint4 o = {pk2(v[0], v[1]), pk2(v[2], v[3]), pk2(v[4], v[5]), pk2(v[6], v[7])};
    *(uint4*)(B.wkv + ((size_t)l * 1024 + n) * 128 + kc * 8) = o;
  }
}

DI void phase_mod(const Params& P, const Bufs& B, char* lds) {
  float* sc = (float*)lds;
  const int tid = otid();
  for (int u = blockIdx.x; u < 192; u += gridDim.x) {
    const int l = u / 96, j0 = (u % 96) * 32;
    __syncthreads();
    for (int i = tid; i < 16 * 1024 / 4; i += 256) ((float4*)sc)[i] = ((const float4*)B.siluc)[i];
    __syncthreads();
    const int jj = tid & 31, kq = tid >> 5;
    float acc[16];
#pragma unroll
    for (int i = 0; i < 16; ++i) acc[i] = 0.f;
    const float* wp = P.w_ada + ((size_t)l * 1024 + kq * 128) * 3072 + j0 + jj;
#pragma unroll 4
    for (int k = 0; k < 128; ++k) {
      const float wv = wp[(size_t)k * 3072];
#pragma unroll
      for (int i = 0; i < 16; ++i) acc[i] += sc[i * 1024 + kq * 128 + k] * wv;
    }
    __syncthreads();
    float* red = (float*)lds;
#pragma unroll
    for (int i = 0; i < 16; ++i) red[(kq * 16 + i) * 32 + jj] = acc[i];
    __syncthreads();
    for (int o = tid; o < 512; o += 256) {
      const int i = o >> 5, j = o & 31;
      float s = 0.f;
#pragma unroll
      for (int q = 0; q < 8; ++q) s += red[(q * 16 + i) * 32 + j];
      B.mod[((size_t)l * 16 + i) * 3072 + j0 + j] = s + P.b_ada[l * 3072 + j0 + j];
    }
  }
  __syncthreads();
}

DI void phase_D(const Params& P, const Bufs& B, int l) {
  const int tid_ = otid(); const int lane = tid_ & 63, w = tid_ >> 6;
  for (int row0 = (blockIdx.x * 4 + w) * 2; row0 < R; row0 += gridDim.x * 8) {
    float4 xv[2][4];
    int mi[2];
#pragma unroll
    for (int r = 0; r < 2; ++r) { const int row = row0 + r; mi[r] = row < NP ? (row >> 12) : 8 + ((row - NP) >> 4); }
    if (l == 0) {
#pragma unroll
      for (int r = 0; r < 2; ++r) {
        const int row = row0 + r;
        const float* xin = row < NP ? P.x_prompt + (size_t)row * 1024 : P.x_sample + (size_t)(row - NP) * 1024;
#pragma unroll
        for (int j = 0; j < 4; ++j) xv[r][j] = ((const float4*)xin)[j * 64 + lane];
      }
    } else {
      uint2 yb[2][4]; float4 xo[2][4];
#pragma unroll
      for (int r = 0; r < 2; ++r) {
        const int row = row0 + r;
        const float* xin = row < NP ? P.x_prompt + (size_t)row * 1024 : P.x_sample + (size_t)(row - NP) * 1024;
        const float* xp = (l == 1) ? xin : P.out + O_Y + (size_t)row * 1024;
        const u16* Yr = B.Y + (size_t)row * 1024;
#pragma unroll
        for (int j = 0; j < 4; ++j) { yb[r][j] = ((const uint2*)Yr)[j * 64 + lane]; xo[r][j] = ((const float4*)xp)[j * 64 + lane]; }
      }
      const float* gp = P.g_post + (size_t)(l - 1) * 1024;
#pragma unroll
      for (int r = 0; r < 2; ++r) {
        const int row = row0 + r;
        float4 yv[4]; float ss = 0.f;
#pragma unroll
        for (int j = 0; j < 4; ++j) {
          yv[j].x = __uint_as_float(yb[r][j].x << 16); yv[j].y = __uint_as_float(yb[r][j].x & 0xffff0000u);
          yv[j].z = __uint_as_float(yb[r][j].y << 16); yv[j].w = __uint_as_float(yb[r][j].y & 0xffff0000u);
          ss += yv[j].x * yv[j].x + yv[j].y * yv[j].y + yv[j].z * yv[j].z + yv[j].w * yv[j].w;
        }
        ss = wave_sum(ss);
        const float rs = rsqrtf(ss * (1.f / 1024.f) + EPSN);
        const float* gate = B.mod + ((size_t)(l - 1) * 16 + mi[r]) * 3072 + 2048;
        float* orow = P.out + O_Y + (size_t)row * 1024;
#pragma unroll
        for (int j = 0; j < 4; ++j) {
          const float4 g = ((const float4*)gate)[j * 64 + lane];
          const float4 q = ((const float4*)gp)[j * 64 + lane];
          xv[r][j].x = xo[r][j].x + g.x * (yv[j].x * rs * q.x); xv[r][j].y = xo[r][j].y + g.y * (yv[j].y * rs * q.y);
          xv[r][j].z = xo[r][j].z + g.z * (yv[j].z * rs * q.z); xv[r][j].w = xo[r][j].w + g.w * (yv[j].w * rs * q.w);
          ((float4*)orow)[j * 64 + lane] = xv[r][j];
        }
      }
    }
    if (l < 2) {
      const float* gp = P.g_pre + (size_t)l * 1024;
#pragma unroll
      for (int r = 0; r < 2; ++r) {
        const int row = row0 + r;
        float ss = 0.f;
#pragma unroll
        for (int j = 0; j < 4; ++j) ss += xv[r][j].x * xv[r][j].x + xv[r][j].y * xv[r][j].y + xv[r][j].z * xv[r][j].z + xv[r][j].w * xv[r][j].w;
        ss = wave_sum(ss);
        const float rs = rsqrtf(ss * (1.f / 1024.f) + EPSN);
        const float* md = B.mod + ((size_t)l * 16 + mi[r]) * 3072;
#pragma unroll
        for (int j = 0; j < 4; ++j) {
          const float4 sh = ((const float4*)md)[j * 64 + lane];
          const float4 scl = ((const float4*)(md + 1024))[j * 64 + lane];
          const float4 g = ((const float4*)gp)[j * 64 + lane];
          const float h0 = xv[r][j].x * rs * g.x * (1.f + scl.x) + sh.x, h1 = xv[r][j].y * rs * g.y * (1.f + scl.y) + sh.y;
          const float h2 = xv[r][j].z * rs * g.z * (1.f + scl.z) + sh.z, h3 = xv[r][j].w * rs * g.w * (1.f + scl.w) + sh.w;
          *(uint2*)(B.H + (size_t)row * 1024 + (j * 64 + lane) * 4) = make_uint2(pk2(h0, h1), pk2(h2, h3));
        }
      }
    }
  }
}

constexpr int GP = 72;
template <class Epi, bool SW>
DI void gemm_tile(const u16* __restrict__ A, int lda, const u16* __restrict__ Bt, int ldb, int K, int m0, int n0, char* lds, const Epi& epi) {
  const int tid = otid(), lane = tid & 63, w = tid >> 6, r32 = lane & 31, hi = lane >> 5;
  const int wm = w >> 1, wn = w & 1;
  u16* As0 = (u16*)lds; u16* Bs0 = As0 + 2 * 128 * GP;
  f32x16 acc00, acc01, acc10, acc11;
#pragma unroll
  for (int i = 0; i < 16; ++i) { acc00[i] = 0.f; acc01[i] = 0.f; acc10[i] = 0.f; acc11[i] = 0.f; }
  const int srow = tid >> 3, skc = tid & 7;
  const u16* Ag = A + (size_t)(m0 + srow) * lda + skc * 8;
  const u16* Bg = Bt + (size_t)(n0 + srow) * ldb + skc * 8;
  const size_t a32 = (size_t)32 * lda, b32 = (size_t)32 * ldb;
  uint4 pa0, pa1, pa2, pa3, pb0, pb1, pb2, pb3;
  uint4 qa0, qa1, qa2, qa3, qb0, qb1, qb2, qb3;
#define GLOAD(S, kt_) { const int ko_ = (kt_) * 64; \
    S##a0 = *(const uint4*)(Ag + ko_); S##a1 = *(const uint4*)(Ag + a32 + ko_); S##a2 = *(const uint4*)(Ag + 2 * a32 + ko_); S##a3 = *(const uint4*)(Ag + 3 * a32 + ko_); \
    S##b0 = *(const uint4*)(Bg + ko_); S##b1 = *(const uint4*)(Bg + b32 + ko_); S##b2 = *(const uint4*)(Bg + 2 * b32 + ko_); S##b3 = *(const uint4*)(Bg + 3 * b32 + ko_); }
#define GSTORE(S, st_) { u16* Aw = As0 + (st_) * 128 * GP + srow * GP + skc * 8; u16* Bw = Bs0 + (st_) * 128 * GP + srow * GP + skc * 8; \
    *(uint4*)(Aw) = S##a0; *(uint4*)(Aw + 32 * GP) = S##a1; *(uint4*)(Aw + 64 * GP) = S##a2; *(uint4*)(Aw + 96 * GP) = S##a3; \
    *(uint4*)(Bw) = S##b0; *(uint4*)(Bw + 32 * GP) = S##b1; *(uint4*)(Bw + 64 * GP) = S##b2; *(uint4*)(Bw + 96 * GP) = S##b3; }
#define GCOMPUTE(st_) { const u16* As = As0 + (st_) * 128 * GP; const u16* Bs = Bs0 + (st_) * 128 * GP; \
    _Pragma("unroll") for (int ks = 0; ks < 4; ++ks) { \
      const bf16x8 a0 = *(const bf16x8*)(As + (wm * 64 + r32) * GP + ks * 16 + hi * 8); \
      const bf16x8 a1 = *(const bf16x8*)(As + (wm * 64 + 32 + r32) * GP + ks * 16 + hi * 8); \
      const bf16x8 b0 = *(const bf16x8*)(Bs + (wn * 64 + r32) * GP + ks * 16 + hi * 8); \
      const bf16x8 b1 = *(const bf16x8*)(Bs + (wn * 64 + 32 + r32) * GP + ks * 16 + hi * 8); \
      if (SW) { acc00 = MFMA(b0, a0, acc00); acc01 = MFMA(b1, a0, acc01); acc10 = MFMA(b0, a1, acc10); acc11 = MFMA(b1, a1, acc11); } \
      else { acc00 = MFMA(a0, b0, acc00); acc01 = MFMA(a0, b1, acc01); acc10 = MFMA(a1, b0, acc10); acc11 = MFMA(a1, b1, acc11); } } }
  const int nk = K >> 6;
  GLOAD(p, 0)
  GLOAD(q, 1)
  GSTORE(p, 0)
  __syncthreads();
  for (int kt = 0; kt < nk; kt += 2) {
    if (kt + 2 < nk) GLOAD(p, kt + 2)
    __builtin_amdgcn_sched_barrier(0);
    GCOMPUTE(0)
    GSTORE(q, 1)
    __syncthreads();
    if (kt + 3 < nk) GLOAD(q, kt + 3)
    __builtin_amdgcn_sched_barrier(0);
    GCOMPUTE(1)
    if (kt + 2 < nk) GSTORE(p, 0)
    __syncthreads();
  }
#undef GLOAD
#undef GSTORE
#undef GCOMPUTE
  epi.template run<SW>(m0 + wm * 64, n0 + wn * 64, acc00, r32, hi);
  epi.template run<SW>(m0 + wm * 64, n0 + wn * 64 + 32, acc01, r32, hi);
  epi.template run<SW>(m0 + wm * 64 + 32, n0 + wn * 64, acc10, r32, hi);
  epi.template run<SW>(m0 + wm * 64 + 32, n0 + wn * 64 + 32, acc11, r32, hi);
}

struct EpiIn {
  const Params& P; const Bufs& B; int l;
  template <bool SW>
  DI void run(int rowbase, int colbase, const f32x16 v, int r32, int hi) const {
    const bool samp = rowbase >= NP;
    if (!SW) {
      const u32 rb = (u32)rowbase + 4u * hi;
      const int seg = colbase >> 8; const u32 c = (colbase & 255) + r32;
      const int grp = seg >> 2;
      const u32 ob = samp ? rb - NP : rb;
      float* o = P.out + (samp ? (grp ? O_SSV : O_SFV) + (size_t)l * 32768 : (grp ? O_PSV : O_PFV) + (size_t)l * 8388608) + ob * 256u + c;
      u16* Vb = (u16*)(P.ws + (samp ? (grp ? WS_VST_S : WS_VFT_S) : (grp ? WS_VST_P : WS_VFT_P)));
#pragma unroll
      for (int g = 0; g < 4; ++g) {
#pragma unroll
        for (int j = 0; j < 4; ++j) o[(8 * g + j) * 256] = v[4 * g + j];
        const u32 row0 = rb + 8 * g, orow0 = ob + 8 * g;
        const u32 bb = samp ? (orow0 >> 4) : (row0 >> 12);
        const u32 t0 = samp ? 2048u + (orow0 & 15u) : (row0 & 4095u);
        const u32 T = samp ? T_S : 4096;
        uint2 pkv = {pk2(v[4 * g], v[4 * g + 1]), pk2(v[4 * g + 2], v[4 * g + 3])};
        *(uint2*)(Vb + ((bb * 256u + c) * T + t0)) = pkv;
      }
      return;
    }
    const u32 tok = (u32)rowbase + r32;
    const u32 otok = samp ? tok - NP : tok;
    if (colbase < 2048) {
      const int seg = colbase >> 8; const u32 c0 = (colbase & 255) + 4u * hi;
      const int kind = seg & 3, grp = seg >> 2;
      if (kind == 0) {
        u16* Q = (u16*)(P.ws + (grp ? WS_QS : WS_QF)) + tok * 256u + c0;
#pragma unroll
        for (int g = 0; g < 4; ++g) *(uint2*)(Q + 8 * g) = make_uint2(pk2(v[4 * g] * QSC, v[4 * g + 1] * QSC), pk2(v[4 * g + 2] * QSC, v[4 * g + 3] * QSC));
      } else if (kind == 1) {
        float* o = P.out + (samp ? (grp ? O_SSK : O_SFK) + (size_t)l * 32768 : (grp ? O_PSK : O_PFK) + (size_t)l * 8388608) + otok * 256u + c0;
        const u32 krow_ = samp ? ((otok >> 4) * T_S + 2048u + (otok & 15u)) : tok;
        u16* Kb = (u16*)(P.ws + (samp ? (grp ? WS_KS_S : WS_KF_S) : (grp ? WS_KS_P : WS_KF_P))) + krow_ * 256u + c0;
#pragma unroll
        for (int g = 0; g < 4; ++g) {
          *(float4*)(o + 8 * g) = make_float4(v[4 * g], v[4 * g + 1], v[4 * g + 2], v[4 * g + 3]);
          *(uint2*)(Kb + 8 * g) = make_uint2(pk2(v[4 * g], v[4 * g + 1]), pk2(v[4 * g + 2], v[4 * g + 3]));
        }
        if (grp == 0 && !samp) {
          float ss = 0.f;
#pragma unroll
          for (int i = 0; i < 16; ++i) ss += v[i] * v[i];
#pragma unroll
          for (int o2 = 16; o2 > 0; o2 >>= 1) ss = fmaxf(ss, __shfl_xor(ss, o2));
          if (r32 == 0) {
            const int hh_ = (colbase & 255) >> 6, part = ((colbase >> 5) & 1) * 2 + hi, bb_ = rowbase >> 12;
            atomicMax((u32*)(P.ws + WS_KMAX) + ((l * 8 + bb_) * 4 + hh_) * 4 + part, __float_as_uint(ss));
          }
        }
      } else {
        u16* G = B.GATE + tok * 1024u + grp * 256 + c0;
#pragma unroll
        for (int g = 0; g < 4; ++g) *(uint2*)(G + 8 * g) = make_uint2(pk2(silu_f(v[4 * g]), silu_f(v[4 * g + 1])), pk2(silu_f(v[4 * g + 2]), silu_f(v[4 * g + 3])));
      }
    } else if (colbase < 2432 || colbase == 2944) {
      float* Tp = B.TMP32 + tok * 416u + (colbase == 2944 ? 384 : colbase - 2048) + 4 * hi;
#pragma unroll
      for (int g = 0; g < 4; ++g) *(float4*)(Tp + 8 * g) = make_float4(v[4 * g], v[4 * g + 1], v[4 * g + 2], v[4 * g + 3]);
    } else if (colbase < 2944) {
      u16* G = B.GATE + tok * 1024u + 512 + (colbase - 2432) + 4 * hi;
#pragma unroll
      for (int g = 0; g < 4; ++g) *(uint2*)(G + 8 * g) = make_uint2(pk2(silu_f(v[4 * g]), silu_f(v[4 * g + 1])), pk2(silu_f(v[4 * g + 2]), silu_f(v[4 * g + 3])));
    } else if (colbase == 2976) {
      if (hi == 0) {
        float lf[4];
#pragma unroll
        for (int j = 0; j < 4; ++j) { const float x = v[j] + P.b_f[l * 4 + j]; lf[j] = fminf(x, 0.f) - __logf(1.f + __expf(-fabsf(x))); }
        const float4 o4 = make_float4(lf[0], lf[1], lf[2], lf[3]);
        *(float4*)(P.out + (samp ? O_SLF + (size_t)l * 512 : O_PLF + (size_t)l * 131072) + otok * 4u) = o4;
        *(float4*)(B.LOGF + tok * 4u) = o4;
      }
    }
  }
};

struct EpiQ {
  const Bufs& B;
  template <bool SW>
  DI void run(int rowbase, int colbase, const f32x16 v, int r32, int hi) const {
    const int within = colbase % 96;
    const u32 tok = (u32)rowbase + r32;
    u16* Q = B.QM + tok * 768u + colbase + 4 * hi;
    if (within < 64) {
#pragma unroll
      for (int g = 0; g < 4; ++g) *(uint2*)(Q + 8 * g) = make_uint2(pk2(v[4 * g] * MSC, v[4 * g + 1] * MSC), pk2(v[4 * g + 2] * MSC, v[4 * g + 3] * MSC));
    } else {
      const int pos = tok < NP ? (int)(tok & 4095u) : 2048 + (int)((tok - NP) & 15u);
#pragma unroll
      for (int g = 0; g < 2; ++g) {
        float o1[4], o2[4];
#pragma unroll
        for (int j = 0; j < 4; ++j) {
          float c, s; rope_cs(pos, 8 * g + 4 * hi + j, c, s);
          const float x1 = v[4 * g + j], x2 = v[4 * (g + 2) + j];
          o1[j] = (x1 * c - x2 * s) * MSC; o2[j] = (x2 * c + x1 * s) * MSC;
        }
        *(uint2*)(Q + 8 * g) = make_uint2(pk2(o1[0], o1[1]), pk2(o1[2], o1[3]));
        *(uint2*)(Q + 8 * (g + 2)) = make_uint2(pk2(o2[0], o2[1]), pk2(o2[2], o2[3]));
      }
    }
  }
};

struct EpiKV {
  const Params& P; int cache;
  template <bool SW>
  DI void run(int rowbase, int colbase, const f32x16 v, int r32, int hi) const {
    if (SW) {
      const u32 tok = (u32)rowbase + r32;
      u32 krow_; size_t base;
      if (cache) { krow_ = (tok >> 11) * T_S + (tok & 2047u); base = WS_KN_S; }
      else if (tok >= NP) { const u32 ot = tok - NP; krow_ = (ot >> 4) * T_S + 2048u + (ot & 15u); base = WS_KN_S; }
      else { krow_ = tok; base = WS_KN_P; }
      u16* Kp = (u16*)(P.ws + base) + krow_ * 512u + colbase + 4 * hi;
#pragma unroll
      for (int g = 0; g < 4; ++g) *(uint2*)(Kp + 8 * g) = make_uint2(pk2(v[4 * g], v[4 * g + 1]), pk2(v[4 * g + 2], v[4 * g + 3]));
    } else {
      const u32 c = (u32)(colbase - 512) + r32;
      const u32 rb = (u32)rowbase + 4u * hi;
#pragma unroll
      for (int g = 0; g < 4; ++g) {
        const u32 row0 = rb + 8 * g;
        u32 bb, t0, T; size_t base;
        if (cache) { bb = row0 >> 11; t0 = row0 & 2047u; T = T_S; base = WS_VM_S; }
        else if (row0 >= NP) { const u32 ot = row0 - NP; bb = ot >> 4; t0 = 2048u + (ot & 15u); T = T_S; base = WS_VM_S; }
        else { bb = row0 >> 12; t0 = row0 & 4095u; T = 4096; base = WS_VM_P; }
        *(uint2*)((u16*)(P.ws + base) + ((bb * 512u + c) * T + t0)) = make_uint2(pk2(v[4 * g], v[4 * g + 1]), pk2(v[4 * g + 2], v[4 * g + 3]));
      }
    }
  }
};

struct EpiY {
  const Bufs& B;
  template <bool SW>
  DI void run(int rowbase, int colbase, const f32x16 v, int r32, int hi) const {
    u16* Yp = B.Y + ((u32)rowbase + r32) * 1024u + colbase + 4 * hi;
#pragma unroll
    for (int g = 0; g < 4; ++g) *(uint2*)(Yp + 8 * g) = make_uint2(pk2(v[4 * g], v[4 * g + 1]), pk2(v[4 * g + 2], v[4 * g + 3]));
  }
};

template <class Epi>
DI void phase_gemm(const u16* A, int lda, const u16* Bt, int ldb, int K, int ntn, char* lds, const Epi& epi, bool vsplit) {
  const int x = blockIdx.x & 7, j = blockIdx.x >> 3, nb = gridDim.x >> 3;
  if (ntn == 24) {
    const int nmt = (x >> 2) ? 129 : 128;
    for (int q = j; q < nmt * 6; q += nb) {
      const int ml = q / 6, nl = q - ml * 6;
      const int mt = (x >> 2) * 128 + ml, nt = (x & 3) * 6 + nl;
      if (vsplit && ((nt & 6) == 4) && nt < 16) gemm_tile<Epi, false>(A, lda, Bt, ldb, K, mt * 128, nt * 128, lds, epi);
      else gemm_tile<Epi, true>(A, lda, Bt, ldb, K, mt * 128, nt * 128, lds, epi);
    }
  } else {
    const int nmt = (x == 0) ? 33 : 32;
    for (int q = j; q < nmt * ntn; q += nb) {
      const int ml = q / ntn, nl = q - ml * ntn;
      const int mt = (ml < 32) ? x * 32 + ml : 256;
      gemm_tile<Epi, true>(A, lda, Bt, ldb, K, mt * 128, nl * 128, lds, epi);
    }
  }
}

DI void phase_A2b(const Params& P, const Bufs& B, int l, char* lds) {
  constexpr int NQ = (R / 128) * 6, NKV = (R / 128) * 8, NKC = 128 * 8;
  const EpiQ eq{B}; const EpiKV ekv{P, 0}; const EpiKV ekc{P, 1};
  const u16* wq = B.wq + (size_t)l * 768 * 256; const u16* wkv = B.wkv + (size_t)l * 1024 * 128;
  for (int t = blockIdx.x; t < NQ + NKV + NKC; t += gridDim.x) {
    if (t < NQ) { const int mt = t / 6, nt = t - mt * 6; gemm_tile<EpiQ, true>(B.CQN, 256, wq, 256, 256, mt * 128, nt * 128, lds, eq); }
    else if (t < NQ + NKV) {
      const int u = t - NQ; const int mt = u >> 3, nt = u & 7;
      if (nt < 4) gemm_tile<EpiKV, true>(B.CKVN, 128, wkv, 128, 128, mt * 128, nt * 128, lds, ekv);
      else gemm_tile<EpiKV, false>(B.CKVN, 128, wkv, 128, 128, mt * 128, nt * 128, lds, ekv);
    } else {
      const int u = t - NQ - NKV; const int mt = u >> 3, nt = u & 7;
      if (nt < 4) gemm_tile<EpiKV, true>(B.CKVC, 128, wkv, 128, 128, mt * 128, nt * 128, lds, ekc);
      else gemm_tile<EpiKV, false>(B.CKVC, 128, wkv, 128, 128, mt * 128, nt * 128, lds, ekc);
    }
  }
}

DI void phase_A2a(const Params& P, const Bufs& B, int l, char* lds) {
  const int tid = otid(), lane = tid & 63, w = tid >> 6;
  if (blockIdx.x < 16) {
    const int itb = blockIdx.x; const bool sp = itb >= 8; const int b = itb & 7;
    const int per = sp ? 9 : 16, total = sp ? 2064 : 4096, TT = sp ? T_S : 4096;
    const float4* c4 = (const float4*)(P.cache_fox_logf + ((size_t)l * 8 + b) * 2048 * 4);
    const float4* n4 = (const float4*)(B.LOGF + (sp ? ((size_t)NP + b * 16) * 4 : (size_t)b * 4096 * 4));
    const float4 zz = {0.f, 0.f, 0.f, 0.f};
    float4 v0 = zz, v1 = zz, v2 = zz, v3 = zz, v4 = zz, v5 = zz, v6 = zz, v7 = zz, v8 = zz, v9 = zz, v10 = zz, v11 = zz, v12 = zz, v13 = zz, v14 = zz, v15 = zz;
    double s0 = 0, s1 = 0, s2 = 0, s3 = 0;
#define FLD(i) if (i < per) { const int t = tid * per + i; if (t < total) v##i = sp ? (t < 2048 ? c4[t] : n4[t - 2048]) : n4[t]; s0 += v##i.x; s1 += v##i.y; s2 += v##i.z; s3 += v##i.w; }
    FLD(0) FLD(1) FLD(2) FLD(3) FLD(4) FLD(5) FLD(6) FLD(7) FLD(8) FLD(9) FLD(10) FLD(11) FLD(12) FLD(13) FLD(14) FLD(15)
#undef FLD
    double e0 = s0, e1 = s1, e2 = s2, e3 = s3;
#pragma unroll
    for (int o = 1; o < 64; o <<= 1) {
      const double t0 = shfl_up_d(e0, o), t1 = shfl_up_d(e1, o), t2 = shfl_up_d(e2, o), t3 = shfl_up_d(e3, o);
      if (lane >= o) { e0 += t0; e1 += t1; e2 += t2; e3 += t3; }
    }
    double* wt = (double*)lds;
    __syncthreads();
    if (lane == 63) { wt[w * 4 + 0] = e0; wt[w * 4 + 1] = e1; wt[w * 4 + 2] = e2; wt[w * 4 + 3] = e3; }
    __syncthreads();
    double r0 = e0 - s0, r1 = e1 - s1, r2 = e2 - s2, r3 = e3 - s3;
    for (int q = 0; q < w; ++q) { r0 += wt[q * 4 + 0]; r1 += wt[q * 4 + 1]; r2 += wt[q * 4 + 2]; r3 += wt[q * 4 + 3]; }
    float* d0 = (float*)(P.ws + (sp ? WS_FS : WS_FP)) + (size_t)b * 4 * TT;
#define FST(i) if (i < per) { const int t = tid * per + i; r0 += v##i.x; r1 += v##i.y; r2 += v##i.z; r3 += v##i.w; \
      if (t < TT) { d0[t] = (float)(r0 * (double)LOG2E); d0[TT + t] = (float)(r1 * (double)LOG2E); d0[2 * TT + t] = (float)(r2 * (double)LOG2E); d0[3 * TT + t] = (float)(r3 * (double)LOG2E); } }
    FST(0) FST(1) FST(2) FST(3) FST(4) FST(5) FST(6) FST(7) FST(8) FST(9) FST(10) FST(11) FST(12) FST(13) FST(14) FST(15)
#undef FST
    __syncthreads();
  }
  for (int g = blockIdx.x * 4 + w; g < R / 4; g += gridDim.x * 4) {
    const int row0 = g * 4;
    const bool samp = row0 >= NP;
    const int orow0 = samp ? row0 - NP : row0;
    const int bb = samp ? (orow0 >> 4) : (row0 >> 12);
    const int t0 = samp ? 2048 + (orow0 & 15) : (row0 & 4095);
    const int T = samp ? T_S : 4096;
    const size_t km0 = samp ? (size_t)bb * T_S + t0 : (size_t)row0;
    u16* KPE = (u16*)(P.ws + (samp ? WS_KPE_S : WS_KPE_P));
    const float4 gq = ((const float4*)(P.g_q_a + l * 256))[lane];
#pragma unroll
    for (int j = 0; j < 4; ++j) {
      const float4 v = *(const float4*)(B.TMP32 + (size_t)(row0 + j) * 416 + lane * 4);
      const float ss = wave_sum(v.x * v.x + v.y * v.y + v.z * v.z + v.w * v.w);
      const float rs = rsqrtf(ss * (1.f / 256.f) + EPSN);
      uint2 o = {pk2(v.x * rs * gq.x, v.y * rs * gq.y), pk2(v.z * rs * gq.z, v.w * rs * gq.w)};
      *(uint2*)(B.CQN + (size_t)(row0 + j) * 256 + lane * 4) = o;
    }
    const float2 gk = ((const float2*)(P.g_kv_a + l * 128))[lane];
    float* ockv = P.out + (samp ? O_SCKV + (size_t)l * 16384 : O_PCKV + (size_t)l * 4194304);
    float n0[4], n1[4];
#pragma unroll
    for (int j = 0; j < 4; ++j) {
      const float2 v = *(const float2*)(B.TMP32 + (size_t)(row0 + j) * 416 + 256 + lane * 2);
      const float ss = wave_sum(v.x * v.x + v.y * v.y);
      const float rs = rsqrtf(ss * (1.f / 128.f) + EPSN);
      n0[j] = v.x * rs * gk.x; n1[j] = v.y * rs * gk.y;
      float2 o = {n0[j], n1[j]};
      *(float2*)(ockv + (size_t)(orow0 + j) * 128 + lane * 2) = o;
      *(u32*)(B.CKVN + (size_t)(row0 + j) * 128 + lane * 2) = pk2(n0[j], n1[j]);
    }
    {
      const int j = lane >> 4, i = lane & 15;
      const float x1 = B.TMP32[(size_t)(row0 + j) * 416 + 384 + i], x2 = B.TMP32[(size_t)(row0 + j) * 416 + 400 + i];
      float c, s; rope_cs(t0 + j, i, c, s);
      const float o1 = x1 * c - x2 * s, o2 = x2 * c + x1 * s;
      float* okpe = P.out + (samp ? O_SKPE + (size_t)l * 4096 : O_PKPE + (size_t)l * 1048576);
      okpe[(size_t)(orow0 + j) * 32 + i] = o1; okpe[(size_t)(orow0 + j) * 32 + 16 + i] = o2;
      KPE[(km0 + j) * 32 + i] = bf1(o1); KPE[(km0 + j) * 32 + 16 + i] = bf1(o2);
    }
  }
  const size_t gtid = (size_t)blockIdx.x * 256 + tid, gsz = (size_t)gridDim.x * 256;
  for (size_t i = gtid; i < (size_t)2 * 8 * 2048 * 32; i += gsz) {
    const int which = (int)(i >> 19); const size_t r = i & 524287; const int cc = (int)(r & 31); const int bt = (int)(r >> 5);
    const int b = bt >> 11, t = bt & 2047;
    const float* src = (which ? P.cache_sb_k : P.cache_fox_k) + (((size_t)l * 8 + b) * 2048 + t) * 256 + cc * 8;
    const float4 v0 = ((const float4*)src)[0], v1 = ((const float4*)src)[1];
    uint4 o = {pk2(v0.x, v0.y), pk2(v0.z, v0.w), pk2(v1.x, v1.y), pk2(v1.z, v1.w)};
    *(uint4*)((u16*)(P.ws + (which ? WS_KS_S : WS_KF_S)) + ((size_t)b * T_S + t) * 256 + cc * 8) = o;
  }
  for (size_t i = gtid; i < (size_t)8 * 2048 * 20; i += gsz) {
    const int cc = (int)(i % 20); const int bt = (int)(i / 20); const int b = bt >> 11, t = bt & 2047;
    const float* srcp = cc < 16 ? P.cache_ckv + (((size_t)l * 8 + b) * 2048 + t) * 128 + cc * 8 : P.cache_kpe + (((size_t)l * 8 + b) * 2048 + t) * 32 + (cc - 16) * 8;
    const float4 v0 = ((const float4*)srcp)[0], v1 = ((const float4*)srcp)[1];
    uint4 o = {pk2(v0.x, v0.y), pk2(v0.z, v0.w), pk2(v1.x, v1.y), pk2(v1.z, v1.w)};
    if (cc < 16) *(uint4*)(B.CKVC + (size_t)bt * 128 + cc * 8) = o;
    else *(uint4*)(B.KPE_S + ((size_t)b * T_S + t) * 32 + (cc - 16) * 8) = o;
  }
  for (size_t i = gtid; i < (size_t)2 * 8 * 256 * 256; i += gsz) {
    const int which = (int)(i >> 19); const size_t r = i & 524287; const int hd = (int)(r & 255); const int t8 = (int)((r >> 8) & 255); const int b = (int)(r >> 16);
    const float* src = (which ? P.cache_sb_v : P.cache_fox_v) + (((size_t)l * 8 + b) * 2048 + t8 * 8) * 256 + hd;
    float v[8];
#pragma unroll
    for (int j = 0; j < 8; ++j) v[j] = src[(size_t)j * 256];
    uint4 o = {pk2(v[0], v[1]), pk2(v[2], v[3]), pk2(v[4], v[5]), pk2(v[6], v[7])};
    *(uint4*)((u16*)(P.ws + (which ? WS_VST_S : WS_VFT_S)) + ((size_t)b * 256 + hd) * T_S + t8 * 8) = o;
  }
  const uint4 z4 = {0u, 0u, 0u, 0u};
  for (size_t i = gtid; i < (size_t)8 * 48 * 32; i += gsz) {
    const int cc = (int)(i & 31); const int r = (int)((i >> 5) % 48); const int b = (int)(i / (48 * 32));
    *(uint4*)(B.KF_S + ((size_t)b * T_S + 2064 + r) * 256 + cc * 8) = z4;
    *(uint4*)(B.KS_S + ((size_t)b * T_S + 2064 + r) * 256 + cc * 8) = z4;
  }
  for (size_t i = gtid; i < (size_t)8 * 48 * 68; i += gsz) {
    const int cc = (int)(i % 68); const int r = (int)((i / 68) % 48); const int b = (int)(i / (48 * 68));
    if (cc < 64) *(uint4*)(B.KN_S + ((size_t)b * T_S + 2064 + r) * 512 + cc * 8) = z4;
    else *(uint4*)(B.KPE_S + ((size_t)b * T_S + 2064 + r) * 32 + (cc - 64) * 8) = z4;
  }
  for (size_t i = gtid; i < (size_t)8 * 512 * 6; i += gsz) {
    const int cc = (int)(i % 6); const int rr = (int)(i / 6);
    *(uint4*)(B.VM_S + (size_t)rr * T_S + 2064 + cc * 8) = z4;
    if (rr < 8 * 256) { *(uint4*)(B.VFT_S + (size_t)rr * T_S + 2064 + cc * 8) = z4; *(uint4*)(B.VST_S + (size_t)rr * T_S + 2064 + cc * 8) = z4; }
  }
}

typedef short v4i16_t __attribute__((ext_vector_type(4)));
DI uint2 lds_tr16(const u16* p) {
  const v4i16_t r = __builtin_amdgcn_ds_read_tr16_b64_v4i16((LAS v4i16_t*)(unsigned)(uintptr_t)p);
  return __builtin_bit_cast(uint2, r);
}
template <int TYPE>
DI void attn_item(const Params& P, const Bufs& B, int l, bool samp, int b, int hh, int qt, char* lds) {
  constexpr int DK = (TYPE == 2) ? 96 : 64, DV = 64;
  constexpr int KP = DK + 8, VP = 68;
  constexpr int NKC = 64 * DK / 8 / 256;
  constexpr int NVC = 2;
  constexpr int NDT = DV / 32;
  constexpr int NST = DK / 16;
  constexpr int STG = 64 * KP * 2 + 64 * VP * 2 + 256;
  const int tid = otid(), lane = tid & 63, w = tid >> 6, r32 = lane & 31, hi = lane >> 5;
  int head, qrow0, nvalid, qpos0, ntiles; bool active;
  if (!samp) { head = hh; qrow0 = b * 4096 + qt * 128 + w * 32; nvalid = 32; qpos0 = qt * 128 + w * 32; ntiles = 2 * qt + 2; active = true; }
  else {
    head = hh; active = (w == 0);
    qrow0 = NP + b * 16; nvalid = 16; qpos0 = 2048; ntiles = 33;
  }
  const int qi = r32 < nvalid ? r32 : nvalid - 1;
  const int qrow = qrow0 + qi, qpos = qpos0 + qi;
  const bool lane_valid = active && (r32 < nvalid);
  const int qlast = qpos0 + nvalid - 1;
  const int klim = samp ? 2064 : ((qpos0 >> 6) + 1) * 64;
  const u16* Kg; const u16* Kg2 = nullptr; const u16* Vg = nullptr; int kpitch, vpitch; const float* Fg = nullptr;
  {
    const int TT = samp ? T_S : 4096;
    vpitch = TT;
    if (TYPE == 2) {
      kpitch = 512;
      Kg = (const u16*)(P.ws + (samp ? WS_KN_S : WS_KN_P)) + (size_t)b * TT * 512 + head * 64;
      Kg2 = (const u16*)(P.ws + (samp ? WS_KPE_S : WS_KPE_P)) + (size_t)b * TT * 32;
      Vg = (const u16*)(P.ws + (samp ? WS_VM_S : WS_VM_P)) + ((size_t)(b * 8 + head) * 64) * TT;
    } else {
      kpitch = 256;
      Kg = (const u16*)(P.ws + (TYPE == 0 ? (samp ? WS_KF_S : WS_KF_P) : (samp ? WS_KS_S : WS_KS_P))) + (size_t)b * TT * 256 + head * 64;
      Vg = (const u16*)(P.ws + (TYPE == 0 ? (samp ? WS_VFT_S : WS_VFT_P) : (samp ? WS_VST_S : WS_VST_P))) + ((size_t)(b * 4 + head) * 64) * TT;
      Fg = (const float*)(P.ws + (samp ? WS_FS : WS_FP)) + (size_t)(b * 4 + head) * TT;
    }
  }
  const bf16x8 zb = {0, 0, 0, 0, 0, 0, 0, 0};
  bf16x8 qf0 = zb, qf1 = zb, qf2 = zb, qf3 = zb, qf4 = zb, qf5 = zb, qf6 = zb, qf7 = zb, qf8 = zb, qf9 = zb;
  {
    const u16* Qp = TYPE == 0 ? B.QF + (size_t)qrow * 256 + head * 64 : TYPE == 1 ? B.QS + (size_t)qrow * 256 + head * 64 : B.QM + (size_t)qrow * 768 + head * 96;
#define QLD(s) if (s < NST) qf##s = *(const bf16x8*)(Qp + s * 16 + hi * 8);
    QLD(0) QLD(1) QLD(2) QLD(3) QLD(4) QLD(5) QLD(6) QLD(7) QLD(8) QLD(9)
#undef QLD
  }
  float zmax = INFINITY;
  if (TYPE == 0 && !samp) {
    const float4 km = *(const float4*)((const float*)(P.ws + WS_KMAX) + ((l * 8 + b) * 4 + head) * 4);
    float qn = 0.f;
#define QSQ(s) _Pragma("unroll") for (int j = 0; j < 8; ++j) { const float x = __uint_as_float(((u32)(u16)qf##s[j]) << 16); qn += x * x; }
    QSQ(0) QSQ(1) QSQ(2) QSQ(3)
#undef QSQ
    qn = halves_sum(qn);
    zmax = sqrtf(qn * (km.x + km.y + km.z + km.w)) * 1.02f + 1e-3f;
  }
  f32x16 zf;
#pragma unroll
  for (int i = 0; i < 16; ++i) zf[i] = 0.f;
  f32x16 O0 = zf, O1 = zf, O2 = zf, O3 = zf;
  float m = (TYPE == 2) ? 0.f : -INFINITY, lsum = 0.f, carry = 1.f;
  f32x16 NM = zf;
  bool first = true;
  bool wdead = !active;
  volatile int* dflags = (volatile int*)(lds + 2 * STG);
  const uint4 z4 = {0u, 0u, 0u, 0u};
  uint4 rak0 = z4, rak1 = z4, rak2 = z4, rav0 = z4, rav1 = z4; float raf_ = 0.f;
  uint4 rbk0 = z4, rbk1 = z4, rbk2 = z4, rbv0 = z4, rbv1 = z4; float rbf_ = 0.f;
#define KLD(S, i) if (i < NKC) { const int c_ = tid + 256 * i; const int row_ = (DK == 64) ? (c_ >> 3) : (c_ / 12); const int cc_ = (DK == 64) ? (c_ & 7) : (c_ - row_ * 12); \
    S##k##i = (DK == 64 || cc_ < 8) ? *(const uint4*)(Kg + (size_t)(k0_ + row_) * kpitch + cc_ * 8) : *(const uint4*)(Kg2 + (size_t)(k0_ + row_) * 32 + (cc_ - 8) * 8); }
#define VLD(S, i) { const int c_ = tid + 256 * i; S##v##i = *(const uint4*)(Vg + (size_t)(c_ >> 3) * vpitch + k0_ + (c_ & 7) * 8); }
#define ATT_PREFETCH(S, it_) { const int k0_ = ((TYPE != 2) ? ntiles - 1 - (it_) : (it_)) * 64; KLD(S, 0) KLD(S, 1) KLD(S, 2) VLD(S, 0) VLD(S, 1) if (TYPE == 0 && tid < 64) S##f_ = Fg[k0_ + tid]; }
#define KST(S, i) if (i < NKC) { const int c_ = tid + 256 * i; const int row_ = (DK == 64) ? (c_ >> 3) : (c_ / 12); const int cc_ = (DK == 64) ? (c_ & 7) : (c_ - row_ * 12); *(uint4*)(KsW + row_ * KP + cc_ * 8) = S##k##i; }
#define VST(S, i) { const int c_ = tid + 256 * i; u16* vd_ = VsW + (c_ >> 3) * VP + (c_ & 7) * 8; *(uint2*)vd_ = make_uint2(S##v##i.x, S##v##i.y); *(uint2*)(vd_ + 4) = make_uint2(S##v##i.z, S##v##i.w); }
#define ATT_STORE(S, st_) { u16* KsW = (u16*)(lds + (st_) * STG); u16* VsW = KsW + 64 * KP; float* FsW = (float*)(VsW + 64 * VP); \
    KST(S, 0) KST(S, 1) KST(S, 2) VST(S, 0) VST(S, 1) if (TYPE == 0 && tid < 64) FsW[tid] = S##f_; }
  auto tile_compute = [&](const int cur, const int it) __attribute__((always_inline)) {
    const int k0 = ((TYPE != 2) ? ntiles - 1 - it : it) * 64;
    const u16* Ks = (const u16*)(lds + cur * STG); const u16* Vs = Ks + 64 * KP; const float* Fs = (const float*)(Vs + 64 * VP);
    if (TYPE == 0 && !wdead) {
      const float bound = zmax - Fs[63];
      wdead = !__any(bound - m > -130.f);
    }
    const bool doit = active && (TYPE == 0 ? (!wdead && k0 <= qlast) : TYPE == 1 ? (!wdead && k0 < qlast) : (k0 < klim));
    if (doit) {
      f32x16 S0 = (TYPE == 2) ? NM : zf, S1 = (TYPE == 2) ? NM : zf;
      bool allzero = false;
#define SBAR __builtin_amdgcn_sched_barrier(0);
#define RD(s) bf16x8 ka##s = zb, kb##s = zb, qq##s = qf##s; if (s < NST) { ka##s = *(const bf16x8*)(Ks + r32 * KP + s * 16 + hi * 8); kb##s = *(const bf16x8*)(Ks + (32 + r32) * KP + s * 16 + hi * 8); \
                }
#define MM(s) if (s < NST) { S0 = MFMA(ka##s, qq##s, S0); S1 = MFMA(kb##s, qq##s, S1); }
      RD(0) RD(1) SBAR RD(2) SBAR MM(0) SBAR RD(3) SBAR MM(1) SBAR RD(4) SBAR MM(2) SBAR RD(5) SBAR MM(3) SBAR RD(6) SBAR MM(4) SBAR
      RD(7) SBAR MM(5) SBAR RD(8) SBAR MM(6) SBAR RD(9) SBAR MM(7) SBAR MM(8) SBAR MM(9) SBAR
#undef RD
#undef MM
      if (TYPE == 1) {
        f32x16 R0, R1;
        const bool need_mask = (k0 + 63 >= qpos0);
#pragma unroll
        for (int i = 0; i < 16; ++i) {
          const float e0 = ex2(fminf(S0[i], 60.f)), e1 = ex2(fminf(S1[i], 60.f));
          const float r0 = __builtin_amdgcn_rcpf(1.f + e0), r1 = __builtin_amdgcn_rcpf(1.f + e1);
          R0[i] = r0; R1[i] = r1; S0[i] = e0 * r0; S1[i] = e1 * r1;
        }
        if (need_mask) {
#pragma unroll
          for (int i = 0; i < 16; ++i) {
            const int key = k0 + crow(i, hi);
            if (!(key < qpos)) { R0[i] = 1.f; S0[i] = 0.f; }
            if (!(key + 32 < qpos)) { R1[i] = 1.f; S1[i] = 0.f; }
          }
        }
        float Rr = carry;
#define SBG(RV, SV, g) { \
          const float gown = (RV[4 * g] * RV[4 * g + 1]) * (RV[4 * g + 2] * RV[4 * g + 3]); \
          const float goth = __shfl_xor(gown, 32); \
          float sfx = hi ? Rr : Rr * goth; \
          SV[4 * g + 3] *= sfx; sfx *= RV[4 * g + 3]; \
          SV[4 * g + 2] *= sfx; sfx *= RV[4 * g + 2]; \
          SV[4 * g + 1] *= sfx; sfx *= RV[4 * g + 1]; \
          SV[4 * g] *= sfx; \
          Rr *= gown * goth; }
        SBG(R1, S1, 3) SBG(R1, S1, 2) SBG(R1, S1, 1) SBG(R1, S1, 0)
        SBG(R0, S0, 3) SBG(R0, S0, 2) SBG(R0, S0, 1) SBG(R0, S0, 0)
#undef SBG
        carry = Rr;
        wdead = !__any(carry != 0.f);
      } else {
        if (TYPE == 0) {
#pragma unroll
          for (int g = 0; g < 4; ++g) {
            const float4 f0 = *(const float4*)(Fs + 8 * g + 4 * hi);
            const float4 f1 = *(const float4*)(Fs + 32 + 8 * g + 4 * hi);
            S0[4 * g] -= f0.x; S0[4 * g + 1] -= f0.y; S0[4 * g + 2] -= f0.z; S0[4 * g + 3] -= f0.w;
            S1[4 * g] -= f1.x; S1[4 * g + 1] -= f1.y; S1[4 * g + 2] -= f1.z; S1[4 * g + 3] -= f1.w;
          }
          if (k0 + 63 > qpos0) {
#pragma unroll
            for (int i = 0; i < 16; ++i) {
              const int key = k0 + crow(i, hi);
              if (key > qpos) S0[i] = -INFINITY;
              if (key + 32 > qpos) S1[i] = -INFINITY;
            }
          }
        } else {
          if (k0 + 64 > klim) {
#pragma unroll
            for (int i = 0; i < 16; ++i) {
              const int key = k0 + crow(i, hi);
              if (key >= klim) S0[i] = -INFINITY;
              if (key + 32 >= klim) S1[i] = -INFINITY;
            }
          }
        }
        float mx = S0[0];
#pragma unroll
        for (int i = 1; i < 16; ++i) mx = fmaxf(mx, S0[i]);
#pragma unroll
        for (int i = 0; i < 16; ++i) mx = fmaxf(mx, S1[i]);
        mx = halves_max(mx);
        if (TYPE == 2) {
          if (first || __any(mx > 8.f)) {
            const float dm = first ? mx : fmaxf(mx, 0.f);
            if (!first) {
              const float alpha = ex2(-dm);
              lsum *= alpha;
#pragma unroll
              for (int i = 0; i < 16; ++i) { O0[i] *= alpha; O1[i] *= alpha; }
            }
            m += dm;
#pragma unroll
            for (int i = 0; i < 16; ++i) { NM[i] = -m; S0[i] -= dm; S1[i] -= dm; }
            first = false;
          }
          float ps = 0.f;
#pragma unroll
          for (int i = 0; i < 16; ++i) { S0[i] = ex2(S0[i]); S1[i] = ex2(S1[i]); ps += S0[i] + S1[i]; }
          lsum += ps;
        } else {
        if (TYPE == 0) allzero = !__any(mx - m > -130.f);
        if (__any(mx > m + 8.f)) {
          const float mnew = fmaxf(m, mx);
          const float alpha = ex2(m - mnew);
          m = mnew;
          lsum *= alpha;
#pragma unroll
          for (int i = 0; i < 16; ++i) { O0[i] *= alpha; O1[i] *= alpha; if (NDT > 2) { O2[i] *= alpha; O3[i] *= alpha; } }
        }
        if (!allzero) {
          float ps = 0.f;
#pragma unroll
          for (int i = 0; i < 16; ++i) { S0[i] = ex2(S0[i] - m); S1[i] = ex2(S1[i] - m); ps += S0[i] + S1[i]; }
          lsum += ps;
        }
        }
      }
      if (!allzero) {
      const bf16x8 pf0 = __builtin_bit_cast(bf16x8, make_uint4(pk2(S0[0], S0[1]), pk2(S0[2], S0[3]), pk2(S0[4], S0[5]), pk2(S0[6], S0[7])));
      const bf16x8 pf1 = __builtin_bit_cast(bf16x8, make_uint4(pk2(S0[8], S0[9]), pk2(S0[10], S0[11]), pk2(S0[12], S0[13]), pk2(S0[14], S0[15])));
      const bf16x8 pf2 = __builtin_bit_cast(bf16x8, make_uint4(pk2(S1[0], S1[1]), pk2(S1[2], S1[3]), pk2(S1[4], S1[5]), pk2(S1[6], S1[7])));
      const bf16x8 pf3 = __builtin_bit_cast(bf16x8, make_uint4(pk2(S1[8], S1[9]), pk2(S1[10], S1[11]), pk2(S1[12], S1[13]), pk2(S1[14], S1[15])));
      const u16* vbase = Vs + r32 * VP + 4 * hi;
#define VRD(d, sp) bf16x8 vf##d##sp = zb; if (d < NDT) { const uint2 lo = *(const uint2*)(vbase + d * 32 * VP + 16 * sp); const uint2 h8 = *(const uint2*)(vbase + d * 32 * VP + 16 * sp + 8); \
        vf##d##sp = __builtin_bit_cast(bf16x8, make_uint4(lo.x, lo.y, h8.x, h8.y)); }
#define VMM(d, sp) if (d < NDT) { O##d = MFMA(vf##d##sp, pf##sp, O##d); }
      VRD(0, 0) VRD(1, 0) VRD(0, 1) SBAR VRD(1, 1) SBAR VMM(0, 0) SBAR VRD(0, 2) SBAR VMM(1, 0) SBAR VRD(1, 2) SBAR VMM(0, 1) SBAR VRD(0, 3) SBAR VMM(1, 1) SBAR VRD(1, 3) SBAR
      VMM(0, 2) SBAR VRD(2, 0) SBAR VMM(1, 2) SBAR VRD(3, 0) SBAR VMM(0, 3) SBAR VRD(2, 1) SBAR VMM(1, 3) SBAR VRD(3, 1) SBAR
      VMM(2, 0) SBAR VRD(2, 2) SBAR VMM(3, 0) SBAR VRD(3, 2) SBAR VMM(2, 1) SBAR VRD(2, 3) SBAR VMM(3, 1) SBAR VRD(3, 3) SBAR
      VMM(2, 2) SBAR VMM(3, 2) SBAR VMM(2, 3) SBAR VMM(3, 3) SBAR
#undef VRD
#undef VMM
#undef SBAR
      }
    }
  };
  ATT_PREFETCH(ra, 0)
  if (ntiles > 1) { ATT_PREFETCH(rb, 1) }
  ATT_STORE(ra, 0)
  __syncthreads();
  for (int it = 0; it < ntiles; it += 2) {
    if (it + 2 < ntiles) { ATT_PREFETCH(ra, it + 2) }
    __builtin_amdgcn_sched_barrier(0);
    tile_compute(0, it);
    if (it + 1 < ntiles) { ATT_STORE(rb, 1) }
    if (TYPE != 2 && lane == 0) dflags[w] = wdead ? 1 : 0;
    __syncthreads();
    if (TYPE != 2) { if (dflags[0] & dflags[1] & dflags[2] & dflags[3]) break; }
    if (it + 1 >= ntiles) break;
    if (it + 3 < ntiles) { ATT_PREFETCH(rb, it + 3) }
    __builtin_amdgcn_sched_barrier(0);
    tile_compute(1, it + 1);
    if (it + 2 < ntiles) { ATT_STORE(ra, 0) }
    if (TYPE != 2 && lane == 0) dflags[4 + w] = wdead ? 1 : 0;
    __syncthreads();
    if (TYPE != 2) { if (dflags[4] & dflags[5] & dflags[6] & dflags[7]) break; }
  }
#undef ATT_PREFETCH
#undef ATT_STORE
#undef KLD
#undef VLD
#undef KST
#undef VST
  if (active) {
    float inv = 1.f;
    if (TYPE != 1) { const float lt = halves_sum(lsum); inv = 1.f / lt; }
    const u32 orow = (u32)qrow * 1024u;
    {
      const int goff = (TYPE == 0 ? 0 : TYPE == 1 ? 256 : 512) + head * 64;
#define OEP(d) _Pragma("unroll") for (int g = 0; g < 4; ++g) { \
          const int dd = d * 32 + 8 * g + 4 * hi; \
          const uint2 gv = *(const uint2*)(B.GATE + orow + goff + dd); \
          const float g0 = __uint_as_float(gv.x << 16), g1 = __uint_as_float(gv.x & 0xffff0000u), g2 = __uint_as_float(gv.y << 16), g3 = __uint_as_float(gv.y & 0xffff0000u); \
          uint2 o = {pk2(O##d[4 * g] * inv * g0, O##d[4 * g + 1] * inv * g1), pk2(O##d[4 * g + 2] * inv * g2, O##d[4 * g + 3] * inv * g3)}; \
          if (lane_valid) *(uint2*)(B.H + orow + goff + dd) = o; }
      OEP(0) OEP(1)
#undef OEP
    }
  }
}

constexpr int N_Q_ITEMS = 16 + 512;
DI void phase_attn(const Params& P, const Bufs& B, int ci, int l, char* lds, int* s_item, int xcc, int only_type = -1) {
  for (int qx = 0; qx < 8; ++qx) {
    const int q = (xcc + qx) & 7;
    while (true) {
      __syncthreads();
      if (threadIdx.x == 0) *s_item = (int)atomicAdd(B.ctr + ci * 8 + q, 1u);
      __syncthreads();
      const int it = *s_item;
      if (it >= N_Q_ITEMS) break;
      bool samp; int type, hh, qt; const int b = q;
      if (it < 16) {
        samp = true; qt = 0;
        if (it < 8) { type = 2; hh = it; } else if (it < 12) { type = 0; hh = it - 8; } else { type = 1; hh = it - 12; }
      } else {
        const int j = it - 16;
        samp = false;
        qt = 31 - (j >> 4); const int k16 = j & 15;
        if (k16 & 1) { type = 2; hh = k16 >> 1; } else if (k16 & 2) { type = 0; hh = k16 >> 2; } else { type = 1; hh = k16 >> 2; }
      }
      if (only_type >= 0 && type != only_type) continue;
      if (type == 0) attn_item<0>(P, B, l, samp, b, hh, qt, lds);
      else if (type == 1) attn_item<1>(P, B, l, samp, b, hh, qt, lds);
      else attn_item<2>(P, B, l, samp, b, hh, qt, lds);
    }
  }
}

__global__ void __launch_bounds__(256, 2) fwd_megakernel(Params P) {
  cg::grid_group grid = cg::this_grid();
  __shared__ __attribute__((aligned(16))) char lds[73728];
  __shared__ int s_item;
  __shared__ uint4 xb_words;
  if (threadIdx.x == 0) xb_words = make_uint4(0u, 0u, 0u, 0u);
  __syncthreads();
  const XcdBarrier xb = xcd_barrier_post((unsigned*)(P.ws + WS_BAR), (volatile LAS unsigned*)&xb_words);
  if (P.ws == nullptr) grid.sync();
  const Bufs B = make_bufs(P.ws);
  phase_prep(P, B);
  xcd_barrier(xb);
  phase_mod(P, B, lds);
  xcd_barrier(xb);
  phase_D(P, B, 0);
  xcd_barrier(xb);
#pragma unroll 1
  for (int l = 0; l < 2; ++l) {
#pragma unroll 1
    for (int rep = 0; rep <= REP_GEMM; ++rep) { EpiIn e{P, B, l}; phase_gemm(B.H, 1024, B.win + (size_t)l * 3072 * 1024, 1024, 1024, 24, lds, e, true); }
    xcd_barrier(xb);
    phase_A2a(P, B, l, lds);
    xcd_barrier(xb);
#pragma unroll 1
    for (int rep = 0; rep <= REP_GEMM; ++rep) phase_A2b(P, B, l, lds);
    xcd_barrier(xb);
#pragma unroll 1
    for (int rep = 0; rep <= REP_ATTN; ++rep) { phase_attn(P, B, l + 2 * rep, l, lds, &s_item, (int)xb.x, rep ? 2 : -1); if (rep < REP_ATTN) xcd_barrier(xb); }
    xcd_barrier(xb);
#pragma unroll 1
    for (int rep = 0; rep <= REP_GEMM; ++rep) { EpiY e{B}; phase_gemm(B.H, 1024, B.wout + (size_t)l * 1024 * 1024, 1024, 1024, 8, lds, e, false); }
    xcd_barrier(xb);
    phase_D(P, B, l + 1);
    if (l == 0) xcd_barrier(xb);
  }
}

extern "C" void kernel_launch(void* const* d_in, const int* in_sizes, int n_in,
                              void* d_out, int out_size, void* d_ws, size_t ws_size,
                              hipStream_t stream) {
  static int grid_blocks = 0;
  if (!grid_blocks) {
    int dev = 0, cus = 0, per_cu = 0;
    (void)hipGetDevice(&dev);
    (void)hipDeviceGetAttribute(&cus, hipDeviceAttributeMultiprocessorCount, dev);
    (void)hipOccupancyMaxActiveBlocksPerMultiprocessor(&per_cu, fwd_megakernel, 256, 0);
    if (per_cu > 2) per_cu = 2;
    if (per_cu < 1) per_cu = 1;
    grid_blocks = cus * per_cu;
    if (ws_size < WS_END) fprintf(stderr, "workspace too small: %zu < %zu\n", ws_size, (size_t)WS_END);
  }
  Params p{};
  const float** pp = (const float**)&p;
  for (int i = 0; i < 23; ++i) pp[i] = (const float*)d_in[i];
  p.out = (float*)d_out;
  p.ws = (unsigned char*)d_ws;
  (void)hipMemsetAsync((char*)d_ws + WS_CTR, 0, 256 + 16384, stream);
  void* args[] = {&p};
  hipError_t e = hipLaunchCooperativeKernel((void*)fwd_megakernel, dim3(grid_blocks), dim3(256), args, 0, stream);
  if (e != hipSuccess) fprintf(stderr, "cooperative launch failed: %s (grid %d)\n", hipGetErrorString(e), grid_blocks);
}
```

```cpp
#include <hip/hip_runtime.h>
#include <hip/hip_cooperative_groups.h>
#include <cstdio>
#include <cstdint>
namespace cg = cooperative_groups;
#define REP_ATTN 0
#define REP_GEMM 0

typedef unsigned short u16;
typedef unsigned int u32;
using bf16x8 = __attribute__((ext_vector_type(8))) short;
using f32x16 = __attribute__((ext_vector_type(16))) float;
typedef __bf16 bf16x2_t __attribute__((ext_vector_type(2)));
typedef float f32x2_t __attribute__((ext_vector_type(2)));
#define DI __device__ __forceinline__
#define MFMA(a, b, c) __builtin_amdgcn_mfma_f32_32x32x16_bf16((a), (b), (c), 0, 0, 0)

constexpr int NP = 32768, NSM = 128, R = NP + NSM;
constexpr int T_S = 2112;
constexpr float LOG2E = 1.4426950408889634f;
constexpr float QSC = 0.125f * LOG2E;
constexpr float MSC = 0.10206207261596575f * LOG2E;
constexpr float EPSN = 1e-6f;

constexpr size_t O_Y = 0;
constexpr size_t O_PFK = (size_t)R * 1024;
constexpr size_t O_PFV = O_PFK + 16777216;
constexpr size_t O_PLF = O_PFV + 16777216;
constexpr size_t O_PSK = O_PLF + 262144;
constexpr size_t O_PSV = O_PSK + 16777216;
constexpr size_t O_PCKV = O_PSV + 16777216;
constexpr size_t O_PKPE = O_PCKV + 8388608;
constexpr size_t O_SFK = O_PKPE + 2097152;
constexpr size_t O_SFV = O_SFK + 65536;
constexpr size_t O_SLF = O_SFV + 65536;
constexpr size_t O_SSK = O_SLF + 1024;
constexpr size_t O_SSV = O_SSK + 65536;
constexpr size_t O_SCKV = O_SSV + 65536;
constexpr size_t O_SKPE = O_SCKV + 32768;

constexpr size_t al256(size_t x) { return (x + 255) & ~(size_t)255; }
constexpr size_t WS_CTR = 0;
constexpr size_t WS_BAR = 256;
constexpr size_t WS_KMAX = 256 + 14336;
constexpr size_t WS_SILUC = 256 + 16384;
constexpr size_t WS_MOD = WS_SILUC + 16 * 1024 * 4;
constexpr size_t WS_WIN = WS_MOD + 2 * 16 * 3072 * 4;
constexpr size_t WS_WQ = WS_WIN + (size_t)2 * 3072 * 1024 * 2;
constexpr size_t WS_WKV = WS_WQ + (size_t)2 * 768 * 256 * 2;
constexpr size_t WS_WOUT = WS_WKV + (size_t)2 * 1024 * 128 * 2;
constexpr size_t WS_H = WS_WOUT + (size_t)2 * 1024 * 1024 * 2;
constexpr size_t WS_GATE = WS_H + (size_t)R * 1024 * 2;
constexpr size_t WS_QM = WS_GATE + (size_t)R * 1024 * 2;
constexpr size_t WS_TMP32 = WS_QM;
constexpr size_t WS_CQN = WS_QM + (size_t)R * 1024 * 2;
constexpr size_t WS_QF = WS_CQN + (size_t)R * 256 * 2;
constexpr size_t WS_QS = WS_QF + (size_t)R * 256 * 2;
constexpr size_t WS_KF_P = WS_QS + (size_t)R * 256 * 2;
constexpr size_t WS_KS_P = WS_KF_P + (size_t)NP * 256 * 2;
constexpr size_t WS_VFT_P = WS_KS_P + (size_t)NP * 256 * 2;
constexpr size_t WS_VST_P = WS_VFT_P + (size_t)NP * 256 * 2;
constexpr size_t WS_KN_P = WS_VST_P + (size_t)NP * 256 * 2;
constexpr size_t WS_KPE_P = WS_KN_P + (size_t)NP * 512 * 2;
constexpr size_t WS_VM_P = WS_KPE_P + (size_t)NP * 32 * 2;
constexpr size_t WS_CKVN = WS_VM_P + (size_t)NP * 512 * 2;
constexpr size_t WS_KF_S = WS_CKVN + (size_t)R * 128 * 2;
constexpr size_t WS_KS_S = WS_KF_S + (size_t)8 * T_S * 256 * 2;
constexpr size_t WS_VFT_S = WS_KS_S + (size_t)8 * T_S * 256 * 2;
constexpr size_t WS_VST_S = WS_VFT_S + (size_t)8 * T_S * 256 * 2;
constexpr size_t WS_KN_S = WS_VST_S + (size_t)8 * T_S * 256 * 2;
constexpr size_t WS_KPE_S = WS_KN_S + (size_t)8 * T_S * 512 * 2;
constexpr size_t WS_VM_S = WS_KPE_S + (size_t)8 * T_S * 32 * 2;
constexpr size_t WS_CKVC = WS_VM_S + (size_t)8 * T_S * 512 * 2;
constexpr size_t WS_LOGF = WS_CKVC + (size_t)8 * 2048 * 128 * 2;
constexpr size_t WS_FP = WS_LOGF + (size_t)R * 4 * 4;
constexpr size_t WS_FS = WS_FP + (size_t)8 * 4 * 4096 * 4;
constexpr size_t WS_END = WS_FS + (size_t)8 * 4 * T_S * 4;
static_assert((size_t)R * 416 * 4 <= (size_t)R * 1024 * 2 && (size_t)R * 768 * 2 <= (size_t)R * 1024 * 2, "aliases must fit");
static_assert(WS_END < (size_t)530 * 1000 * 1000, "workspace too large");

struct Params {
  const float* x_prompt; const float* x_sample; const float* c_prompt; const float* c_sample;
  const float* cache_fox_k; const float* cache_fox_v; const float* cache_fox_logf;
  const float* cache_sb_k; const float* cache_sb_v; const float* cache_ckv; const float* cache_kpe;
  const float* g_pre; const float* g_post; const float* w_ada; const float* b_ada; const float* w_in;
  const float* b_f; const float* g_q_a; const float* w_uq; const float* g_kv_a; const float* w_uk;
  const float* w_uv; const float* w_out;
  float* out;
  unsigned char* ws;
};

DI u32 pk2(float a, float b) { f32x2_t v = {a, b}; bf16x2_t r = __builtin_convertvector(v, bf16x2_t); return __builtin_bit_cast(u32, r); }
DI u16 bf1(float a) { return (u16)(pk2(a, 0.f) & 0xffffu); }
DI int crow(int i, int hi) { return (i & 3) + 8 * (i >> 2) + 4 * hi; }
DI float wave_sum(float v) {
#pragma unroll
  for (int o = 32; o > 0; o >>= 1) v += __shfl_xor(v, o);
  return v;
}
DI double shfl_up_d(double x, int o) { int lo = __double2loint(x), hi = __double2hiint(x); lo = __shfl_up(lo, o); hi = __shfl_up(hi, o); return __hiloint2double(hi, lo); }
DI int otid() { int t = threadIdx.x; asm volatile("" : "+v"(t)); return t; }
DI float ex2(float x) { return __builtin_amdgcn_exp2f(x); }
DI float lg2(float x) { return __builtin_amdgcn_logf(x); }
DI float silu_f(float v) { return v * __builtin_amdgcn_rcpf(1.f + __expf(-v)); }
DI float halves_sum(float x) { auto rr = __builtin_amdgcn_permlane32_swap(__float_as_uint(x), __float_as_uint(x), false, false); return __uint_as_float(rr[0]) + __uint_as_float(rr[1]); }
DI float halves_max(float x) { auto rr = __builtin_amdgcn_permlane32_swap(__float_as_uint(x), __float_as_uint(x), false, false); return fmaxf(__uint_as_float(rr[0]), __uint_as_float(rr[1])); }
DI void rope_cs(int pos, int fidx, float& c, float& s) {
  const float inv = ex2(-(float)fidx * (13.287712379549449f / 16.f));
  float rev = ((float)pos * inv) * 0.15915494309189535f;
  rev = rev - floorf(rev);
  s = __builtin_amdgcn_sinf(rev); c = __builtin_amdgcn_cosf(rev);
}

struct Bufs {
  u32* ctr; float* siluc; float* mod; u16* win; u16* wq; u16* wkv; u16* wout; u16* H; u16* GATE; u16* QM; u16* Y; float* TMP32;
  u16* CQN; u16* QF; u16* QS; u16* KF_P; u16* KS_P; u16* VFT_P; u16* VST_P; u16* KN_P; u16* KPE_P; u16* VM_P; u16* CKVN;
  u16* KF_S; u16* KS_S; u16* VFT_S; u16* VST_S; u16* KN_S; u16* KPE_S; u16* VM_S; u16* CKVC; float* LOGF; float* FP; float* FS;
};
DI Bufs make_bufs(unsigned char* ws) {
  Bufs B;
  B.ctr = (u32*)(ws + WS_CTR); B.siluc = (float*)(ws + WS_SILUC); B.mod = (float*)(ws + WS_MOD); B.win = (u16*)(ws + WS_WIN);
  B.wq = (u16*)(ws + WS_WQ); B.wkv = (u16*)(ws + WS_WKV); B.wout = (u16*)(ws + WS_WOUT); B.H = (u16*)(ws + WS_H); B.GATE = (u16*)(ws + WS_GATE);
  B.QM = (u16*)(ws + WS_QM); B.Y = (u16*)(ws + WS_QM); B.TMP32 = (float*)(ws + WS_TMP32); B.CQN = (u16*)(ws + WS_CQN);
  B.QF = (u16*)(ws + WS_QF); B.QS = (u16*)(ws + WS_QS); B.KF_P = (u16*)(ws + WS_KF_P); B.KS_P = (u16*)(ws + WS_KS_P);
  B.VFT_P = (u16*)(ws + WS_VFT_P); B.VST_P = (u16*)(ws + WS_VST_P); B.KN_P = (u16*)(ws + WS_KN_P); B.KPE_P = (u16*)(ws + WS_KPE_P); B.VM_P = (u16*)(ws + WS_VM_P); B.CKVN = (u16*)(ws + WS_CKVN);
  B.KF_S = (u16*)(ws + WS_KF_S); B.KS_S = (u16*)(ws + WS_KS_S); B.VFT_S = (u16*)(ws + WS_VFT_S); B.VST_S = (u16*)(ws + WS_VST_S);
  B.KN_S = (u16*)(ws + WS_KN_S); B.KPE_S = (u16*)(ws + WS_KPE_S); B.VM_S = (u16*)(ws + WS_VM_S); B.CKVC = (u16*)(ws + WS_CKVC); B.LOGF = (float*)(ws + WS_LOGF); B.FP = (float*)(ws + WS_FP); B.FS = (float*)(ws + WS_FS);
  return B;
}


#define XB_TMO      128
#define XB_XCNT(j)  (256  + 64 * (j))
#define XB_XSUB(j)  (1280 + 64 * (j))
#define XB_XGEN(j)  (2304 + 64 * (j))
#define XB_TOP      3328
#define XB_TOPGEN   3392
#define XCD_BAR_WORDS 3456
#define XB_SPIN_CAP (1u << 22)
#define LAS __attribute__((address_space(3)))
DI unsigned xb_ld(unsigned* p) { return __hip_atomic_load(p, __ATOMIC_RELAXED, __HIP_MEMORY_SCOPE_AGENT); }
DI unsigned xb_add(unsigned* p, unsigned v) { return __hip_atomic_fetch_add(p, v, __ATOMIC_RELAXED, __HIP_MEMORY_SCOPE_AGENT); }
DI unsigned xb_xcc_id() { return (unsigned)__builtin_amdgcn_s_getreg((3 << 11) | 20) & 0xFu; }
#define XB_SPIN(cond, bar) do { unsigned _sp = 0; while (cond) { __builtin_amdgcn_s_sleep(1); \
    if ((++_sp & 255u) == 0u) { if (xb_ld(&(bar)[XB_TMO])) break; if (_sp > XB_SPIN_CAP) { atomicAdd(&(bar)[XB_TMO], 1u); break; } } } } while (0)
struct XcdBarrier { unsigned* bar; unsigned x; volatile LAS unsigned* st; };
DI XcdBarrier xcd_barrier_post(unsigned* bar, volatile LAS unsigned* st) {
  XcdBarrier b; b.bar = bar; b.x = xb_xcc_id(); b.st = st;
  if (threadIdx.x == 0) (void)xb_add(&bar[XB_XCNT(b.x)], 1u);
  return b;
}
DI void xcd_barrier_complete(unsigned* bar, unsigned x, unsigned& nloc, unsigned& nx) {
  const unsigned G = gridDim.x * gridDim.y * gridDim.z;
  unsigned sum, cnt, mine, sp = 0u;
  for (;;) {
    sum = 0u; cnt = 0u; mine = 0u;
#pragma unroll
    for (unsigned j = 0; j < 16; ++j) { const unsigned c = xb_ld(&bar[XB_XCNT(j)]); sum += c; cnt += (c > 0u) ? 1u : 0u; mine = (j == x) ? c : mine; }
    if (sum == G) break;
    __builtin_amdgcn_s_sleep(1);
    if ((++sp & 255u) == 0u) { if (xb_ld(&bar[XB_TMO])) break; if (sp > XB_SPIN_CAP) { atomicAdd(&bar[XB_TMO], 1u); break; } }
  }
  nloc = mine > 0u ? mine : 1u; nx = cnt > 0u ? cnt : 1u;
}
DI void xcd_barrier(const XcdBarrier& b) {
  asm volatile("s_waitcnt vmcnt(0)" ::: "memory");
  __syncthreads();
  if (threadIdx.x == 0) {
    unsigned* bar = b.bar;
    __builtin_amdgcn_s_waitcnt(0);
    unsigned nloc = b.st[0], nx = b.st[1];
    if (nloc == 0u) { xcd_barrier_complete(bar, b.x, nloc, nx); b.st[0] = nloc; b.st[1] = nx; }
    const unsigned old = xb_add(&bar[XB_XSUB(b.x)], 1u);
    const unsigned gen = old / nloc;
    if (old + 1u == (gen + 1u) * nloc) {
      __builtin_amdgcn_fence(__ATOMIC_RELEASE, "agent");
      asm volatile("s_waitcnt vmcnt(0)" ::: "memory");
      const unsigned og = xb_add(&bar[XB_TOP], 1u);
      const unsigned tg = og / nx;
      if (og + 1u == (tg + 1u) * nx) xb_add(&bar[XB_TOPGEN], 1u);
      else XB_SPIN(xb_ld(&bar[XB_TOPGEN]) == tg, bar);
      __builtin_amdgcn_fence(__ATOMIC_ACQUIRE, "agent");
      xb_add(&bar[XB_XGEN(b.x)], 1u);
      asm volatile("s_waitcnt vmcnt(0)" ::: "memory");
    } else {
      XB_SPIN(xb_ld(&bar[XB_XGEN(b.x)]) == gen, bar);
      __builtin_amdgcn_fence(__ATOMIC_ACQUIRE, "agent");
      asm volatile("s_waitcnt vmcnt(0)" ::: "memory");
    }
  }
  __syncthreads();
}

DI int in_colmap(int n) { return n < 768 ? n : n < 2432 ? n + 4 : n < 2944 ? n + 36 : n < 2976 ? n - 508 : n < 2980 ? n - 2208 : -1; }

DI void phase_prep(const Params& P, const Bufs& B) {
  const size_t gtid = (size_t)blockIdx.x * 256 + otid(), gsz = (size_t)gridDim.x * 256;
  for (size_t i = gtid; i < 16 * 1024; i += gsz) {
    const float c = i < 8192 ? P.c_prompt[i] : P.c_sample[i - 8192];
    B.siluc[i] = c / (1.f + __expf(-c));
  }
  for (size_t i = gtid; i < (size_t)2 * 128 * 3072; i += gsz) {
    const int n = (int)(i % 3072); const int kc = (int)((i / 3072) % 128); const int l = (int)(i / (3072 * 128));
    const int col = in_colmap(n);
    float v[8];
#pragma unroll
    for (int j = 0; j < 8; ++j) v[j] = col >= 0 ? P.w_in[((size_t)l * 1024 + kc * 8 + j) * 2980 + col] : 0.f;
    uint4 o = {pk2(v[0], v[1]), pk2(v[2], v[3]), pk2(v[4], v[5]), pk2(v[6], v[7])};
    *(uint4*)(B.win + ((size_t)l * 3072 + n) * 1024 + kc * 8) = o;
  }
  for (size_t i = gtid; i < (size_t)2 * 128 * 1024; i += gsz) {
    const int n = (int)(i & 1023); const int kc = (int)((i >> 10) & 127); const int l = (int)(i >> 17);
    float v[8];
#pragma unroll
    for (int j = 0; j < 8; ++j) v[j] = P.w_out[((size_t)l * 1024 + kc * 8 + j) * 1024 + n];
    uint4 o = {pk2(v[0], v[1]), pk2(v[2], v[3]), pk2(v[4], v[5]), pk2(v[6], v[7])};
    *(uint4*)(B.wout + ((size_t)l * 1024 + n) * 1024 + kc * 8) = o;
  }
  for (size_t i = gtid; i < (size_t)2 * 32 * 768; i += gsz) {
    const int n = (int)(i % 768); const int kc = (int)((i / 768) & 31); const int l = (int)(i / (768 * 32));
    float v[8];
#pragma unroll
    for (int j = 0; j < 8; ++j) v[j] = P.w_uq[((size_t)l * 256 + kc * 8 + j) * 768 + n];
    uint4 o = {pk2(v[0], v[1]), pk2(v[2], v[3]), pk2(v[4], v[5]), pk2(v[6], v[7])};
    *(uint4*)(B.wq + ((size_t)l * 768 + n) * 256 + kc * 8) = o;
  }
  for (size_t i = gtid; i < (size_t)2 * 16 * 1024; i += gsz) {
    const int n = (int)(i & 1023); const int kc = (int)((i >> 10) & 15); const int l = (int)(i >> 14);
    const float* srcw = (n < 512 ? P.w_uk : P.w_uv) + (size_t)l * 128 * 512 + (n & 511);
    float v[8];
#pragma unroll
    for (int j = 0; j < 8; ++j) v[j] = srcw[(size_t)(kc * 8 + j) * 512];
    uint4 o = {pk2(v[0], v[1]), pk2(v[2], v[3]), pk2(v[4], v[5]), pk2(v[6], v[7])};
    *(uint4*)(B.wkv + ((size_t)l * 1024 + n) * 128 + kc * 8) = o;
  }
}

DI void phase_mod(const Params& P, const Bufs& B, char* lds) {
  float* sc = (float*)lds;
  const int tid = otid();
  for (int u = blockIdx.x; u < 192; u += gridDim.x) {
    const int l = u / 96, j0 = (u % 96) * 32;
    __syncthreads();
    for (int i = tid; i < 16 * 1024 / 4; i += 256) ((float4*)sc)[i] = ((const float4*)B.siluc)[i];
    __syncthreads();
    const int jj = tid & 31, kq = tid >> 5;
    float acc[16];
#pragma unroll
    for (int i = 0; i < 16; ++i) acc[i] = 0.f;
    const float* wp = P.w_ada + ((size_t)l * 1024 + kq * 128) * 3072 + j0 + jj;
#pragma unroll 4
    for (int k = 0; k < 128; ++k) {
      const float wv = wp[(size_t)k * 3072];
#pragma unroll
      for (int i = 0; i < 16; ++i) acc[i] += sc[i * 1024 + kq * 128 + k] * wv;
    }
    __syncthreads();
    float* red = (float*)lds;
#pragma unroll
    for (int i = 0; i < 16; ++i) red[(kq * 16 + i) * 32 + jj] = acc[i];
    __syncthreads();
    for (int o = tid; o < 512; o += 256) {
      const int i = o >> 5, j = o & 31;
      float s = 0.f;
#pragma unroll
      for (int q = 0; q < 8; ++q) s += red[(q * 16 + i) * 32 + j];
      B.mod[((size_t)l * 16 + i) * 3072 + j0 + j] = s + P.b_ada[l * 3072 + j0 + j];
    }
  }
  __syncthreads();
}

DI void phase_D(const Params& P, const Bufs& B, int l) {
  const int tid_ = otid(); const int lane = tid_ & 63, w = tid_ >> 6;
  for (int row0 = (blockIdx.x * 4 + w) * 2; row0 < R; row0 += gridDim.x * 8) {
    float4 xv[2][4];
    int mi[2];
#pragma unroll
    for (int r = 0; r < 2; ++r) { const int row = row0 + r; mi[r] = row < NP ? (row >> 12) : 8 + ((row - NP) >> 4); }
    if (l == 0) {
#pragma unroll
      for (int r = 0; r < 2; ++r) {
        const int row = row0 + r;
        const float* xin = row < NP ? P.x_prompt + (size_t)row * 1024 : P.x_sample + (size_t)(row - NP) * 1024;
#pragma unroll
        for (int j = 0; j < 4; ++j) xv[r][j] = ((const float4*)xin)[j * 64 + lane];
      }
    } else {
      uint2 yb[2][4]; float4 xo[2][4];
#pragma unroll
      for (int r = 0; r < 2; ++r) {
        const int row = row0 + r;
        const float* xin = row < NP ? P.x_prompt + (size_t)row * 1024 : P.x_sample + (size_t)(row - NP) * 1024;
        const float* xp = (l == 1) ? xin : P.out + O_Y + (size_t)row * 1024;
        const u16* Yr = B.Y + (size_t)row * 1024;
#pragma unroll
        for (int j = 0; j < 4; ++j) { yb[r][j] = ((const uint2*)Yr)[j * 64 + lane]; xo[r][j] = ((const float4*)xp)[j * 64 + lane]; }
      }
      const float* gp = P.g_post + (size_t)(l - 1) * 1024;
#pragma unroll
      for (int r = 0; r < 2; ++r) {
        const int row = row0 + r;
        float4 yv[4]; float ss = 0.f;
#pragma unroll
        for (int j = 0; j < 4; ++j) {
          yv[j].x = __uint_as_float(yb[r][j].x << 16); yv[j].y = __uint_as_float(yb[r][j].x & 0xffff0000u);
          yv[j].z = __uint_as_float(yb[r][j].y << 16); yv[j].w = __uint_as_float(yb[r][j].y & 0xffff0000u);
          ss += yv[j].x * yv[j].x + yv[j].y * yv[j].y + yv[j].z * yv[j].z + yv[j].w * yv[j].w;
        }
        ss = wave_sum(ss);
        const float rs = rsqrtf(ss * (1.f / 1024.f) + EPSN);
        const float* gate = B.mod + ((size_t)(l - 1) * 16 + mi[r]) * 3072 + 2048;
        float* orow = P.out + O_Y + (size_t)row * 1024;
#pragma unroll
        for (int j = 0; j < 4; ++j) {
          const float4 g = ((const float4*)gate)[j * 64 + lane];
          const float4 q = ((const float4*)gp)[j * 64 + lane];
          xv[r][j].x = xo[r][j].x + g.x * (yv[j].x * rs * q.x); xv[r][j].y = xo[r][j].y + g.y * (yv[j].y * rs * q.y);
          xv[r][j].z = xo[r][j].z + g.z * (yv[j].z * rs * q.z); xv[r][j].w = xo[r][j].w + g.w * (yv[j].w * rs * q.w);
          ((float4*)orow)[j * 64 + lane] = xv[r][j];
        }
      }
    }
    if (l < 2) {
      const float* gp = P.g_pre + (size_t)l * 1024;
#pragma unroll
      for (int r = 0; r < 2; ++r) {
        const int row = row0 + r;
        float ss = 0.f;
#pragma unroll
        for (int j = 0; j < 4; ++j) ss += xv[r][j].x * xv[r][j].x + xv[r][j].y * xv[r][j].y + xv[r][j].z * xv[r][j].z + xv[r][j].w * xv[r][j].w;
        ss = wave_sum(ss);
        const float rs = rsqrtf(ss * (1.f / 1024.f) + EPSN);
        const float* md = B.mod + ((size_t)l * 16 + mi[r]) * 3072;
#pragma unroll
        for (int j = 0; j < 4; ++j) {
          const float4 sh = ((const float4*)md)[j * 64 + lane];
          const float4 scl = ((const float4*)(md + 1024))[j * 64 + lane];
          const float4 g = ((const float4*)gp)[j * 64 + lane];
          const float h0 = xv[r][j].x * rs * g.x * (1.f + scl.x) + sh.x, h1 = xv[r][j].y * rs * g.y * (1.f + scl.y) + sh.y;
          const float h2 = xv[r][j].z * rs * g.z * (1.f + scl.z) + sh.z, h3 = xv[r][j].w * rs * g.w * (1.f + scl.w) + sh.w;
          *(uint2*)(B.H + (size_t)row * 1024 + (j * 64 + lane) * 4) = make_uint2(pk2(h0, h1), pk2(h2, h3));
        }
      }
    }
  }
}

constexpr int GP = 72;
template <class Epi, bool SW>
DI void gemm_tile(const u16* __restrict__ A, int lda, const u16* __restrict__ Bt, int ldb, int K, int m0, int n0, char* lds, const Epi& epi) {
  const int tid = otid(), lane = tid & 63, w = tid >> 6, r32 = lane & 31, hi = lane >> 5;
  const int wm = w >> 1, wn = w & 1;
  u16* As0 = (u16*)lds; u16* Bs0 = As0 + 2 * 128 * GP;
  f32x16 acc00, acc01, acc10, acc11;
#pragma unroll
  for (int i = 0; i < 16; ++i) { acc00[i] = 0.f; acc01[i] = 0.f; acc10[i] = 0.f; acc11[i] = 0.f; }
  const int srow = tid >> 3, skc = tid & 7;
  const u16* Ag = A + (size_t)(m0 + srow) * lda + skc * 8;
  const u16* Bg = Bt + (size_t)(n0 + srow) * ldb + skc * 8;
  const size_t a32 = (size_t)32 * lda, b32 = (size_t)32 * ldb;
  uint4 pa0, pa1, pa2, pa3, pb0, pb1, pb2, pb3;
  uint4 qa0, qa1, qa2, qa3, qb0, qb1, qb2, qb3;
#define GLOAD(S, kt_) { const int ko_ = (kt_) * 64; \
    S##a0 = *(const uint4*)(Ag + ko_); S##a1 = *(const uint4*)(Ag + a32 + ko_); S##a2 = *(const uint4*)(Ag + 2 * a32 + ko_); S##a3 = *(const uint4*)(Ag + 3 * a32 + ko_); \
    S##b0 = *(const uint4*)(Bg + ko_); S##b1 = *(const uint4*)(Bg + b32 + ko_); S##b2 = *(const uint4*)(Bg + 2 * b32 + ko_); S##b3 = *(const uint4*)(Bg + 3 * b32 + ko_); }
#define GSTORE(S, st_) { u16* Aw = As0 + (st_) * 128 * GP + srow * GP + skc * 8; u16* Bw = Bs0 + (st_) * 128 * GP + srow * GP + skc * 8; \
    *(uint4*)(Aw) = S##a0; *(uint4*)(Aw + 32 * GP) = S##a1; *(uint4*)(Aw + 64 * GP) = S##a2; *(uint4*)(Aw + 96 * GP) = S##a3; \
    *(uint4*)(Bw) = S##b0; *(uint4*)(Bw + 32 * GP) = S##b1; *(uint4*)(Bw + 64 * GP) = S##b2; *(uint4*)(Bw + 96 * GP) = S##b3; }
#define GCOMPUTE(st_) { const u16* As = As0 + (st_) * 128 * GP; const u16* Bs = Bs0 + (st_) * 128 * GP; __builtin_amdgcn_s_setprio(1); \
    _Pragma("unroll") for (int ks = 0; ks < 4; ++ks) { \
      const bf16x8 a0 = *(const bf16x8*)(As + (wm * 64 + r32) * GP + ks * 16 + hi * 8); \
      const bf16x8 a1 = *(const bf16x8*)(As + (wm * 64 + 32 + r32) * GP + ks * 16 + hi * 8); \
      const bf16x8 b0 = *(const bf16x8*)(Bs + (wn * 64 + r32) * GP + ks * 16 + hi * 8); \
      const bf16x8 b1 = *(const bf16x8*)(Bs + (wn * 64 + 32 + r32) * GP + ks * 16 + hi * 8); \
      if (SW) { acc00 = MFMA(b0, a0, acc00); acc01 = MFMA(b1, a0, acc01); acc10 = MFMA(b0, a1, acc10); acc11 = MFMA(b1, a1, acc11); } \
      else { acc00 = MFMA(a0, b0, acc00); acc01 = MFMA(a0, b1, acc01); acc10 = MFMA(a1, b0, acc10); acc11 = MFMA(a1, b1, acc11); } } __builtin_amdgcn_s_setprio(0); }
  const int nk = K >> 6;
  GLOAD(p, 0)
  GLOAD(q, 1)
  GSTORE(p, 0)
  __syncthreads();
  for (int kt = 0; kt < nk; kt += 2) {
    if (kt + 2 < nk) GLOAD(p, kt + 2)
    __builtin_amdgcn_sched_barrier(0);
    GCOMPUTE(0)
    GSTORE(q, 1)
    __syncthreads();
    if (kt + 3 < nk) GLOAD(q, kt + 3)
    __builtin_amdgcn_sched_barrier(0);
    GCOMPUTE(1)
    if (kt + 2 < nk) GSTORE(p, 0)
    __syncthreads();
  }
#undef GLOAD
#undef GSTORE
#undef GCOMPUTE
  epi.template run<SW>(m0 + wm * 64, n0 + wn * 64, acc00, r32, hi);
  epi.template run<SW>(m0 + wm * 64, n0 + wn * 64 + 32, acc01, r32, hi);
  epi.template run<SW>(m0 + wm * 64 + 32, n0 + wn * 64, acc10, r32, hi);
  epi.template run<SW>(m0 + wm * 64 + 32, n0 + wn * 64 + 32, acc11, r32, hi);
}

struct EpiIn {
  const Params& P; const Bufs& B; int l;
  template <bool SW>
  DI void run(int rowbase, int colbase, const f32x16 v, int r32, int hi) const {
    const bool samp = rowbase >= NP;
    if (!SW) {
      const u32 rb = (u32)rowbase + 4u * hi;
      const int seg = colbase >> 8; const u32 c = (colbase & 255) + r32;
      const int grp = seg >> 2;
      const u32 ob = samp ? rb - NP : rb;
      float* o = P.out + (samp ? (grp ? O_SSV : O_SFV) + (size_t)l * 32768 : (grp ? O_PSV : O_PFV) + (size_t)l * 8388608) + ob * 256u + c;
      u16* Vb = (u16*)(P.ws + (samp ? (grp ? WS_VST_S : WS_VFT_S) : (grp ? WS_VST_P : WS_VFT_P)));
#pragma unroll
      for (int g = 0; g < 4; ++g) {
#pragma unroll
        for (int j = 0; j < 4; ++j) o[(8 * g + j) * 256] = v[4 * g + j];
        const u32 row0 = rb + 8 * g, orow0 = ob + 8 * g;
        const u32 bb = samp ? (orow0 >> 4) : (row0 >> 12);
        const u32 t0 = samp ? 2048u + (orow0 & 15u) : (row0 & 4095u);
        const u32 T = samp ? T_S : 4096;
        uint2 pkv = {pk2(v[4 * g], v[4 * g + 1]), pk2(v[4 * g + 2], v[4 * g + 3])};
        *(uint2*)(Vb + ((bb * 256u + c) * T + t0)) = pkv;
      }
      return;
    }
    const u32 tok = (u32)rowbase + r32;
    const u32 otok = samp ? tok - NP : tok;
    if (colbase < 2048) {
      const int seg = colbase >> 8; const u32 c0 = (colbase & 255) + 4u * hi;
      const int kind = seg & 3, grp = seg >> 2;
      if (kind == 0) {
        u16* Q = (u16*)(P.ws + (grp ? WS_QS : WS_QF)) + tok * 256u + c0;
#pragma unroll
        for (int g = 0; g < 4; ++g) *(uint2*)(Q + 8 * g) = make_uint2(pk2(v[4 * g] * QSC, v[4 * g + 1] * QSC), pk2(v[4 * g + 2] * QSC, v[4 * g + 3] * QSC));
      } else if (kind == 1) {
        float* o = P.out + (samp ? (grp ? O_SSK : O_SFK) + (size_t)l * 32768 : (grp ? O_PSK : O_PFK) + (size_t)l * 8388608) + otok * 256u + c0;
        const u32 krow_ = samp ? ((otok >> 4) * T_S + 2048u + (otok & 15u)) : tok;
        u16* Kb = (u16*)(P.ws + (samp ? (grp ? WS_KS_S : WS_KF_S) : (grp ? WS_KS_P : WS_KF_P))) + krow_ * 256u + c0;
#pragma unroll
        for (int g = 0; g < 4; ++g) {
          *(float4*)(o + 8 * g) = make_float4(v[4 * g], v[4 * g + 1], v[4 * g + 2], v[4 * g + 3]);
          *(uint2*)(Kb + 8 * g) = make_uint2(pk2(v[4 * g], v[4 * g + 1]), pk2(v[4 * g + 2], v[4 * g + 3]));
        }
        if (grp == 0 && !samp) {
          float ss = 0.f;
#pragma unroll
          for (int i = 0; i < 16; ++i) ss += v[i] * v[i];
#pragma unroll
          for (int o2 = 16; o2 > 0; o2 >>= 1) ss = fmaxf(ss, __shfl_xor(ss, o2));
          if (r32 == 0) {
            const int hh_ = (colbase & 255) >> 6, part = ((colbase >> 5) & 1) * 2 + hi, bb_ = rowbase >> 12;
            atomicMax((u32*)(P.ws + WS_KMAX) + ((l * 8 + bb_) * 4 + hh_) * 4 + part, __float_as_uint(ss));
          }
        }
      } else {
        u16* G = B.GATE + tok * 1024u + grp * 256 + c0;
#pragma unroll
        for (int g = 0; g < 4; ++g) *(uint2*)(G + 8 * g) = make_uint2(pk2(silu_f(v[4 * g]), silu_f(v[4 * g + 1])), pk2(silu_f(v[4 * g + 2]), silu_f(v[4 * g + 3])));
      }
    } else if (colbase < 2432 || colbase == 2944) {
      float* Tp = B.TMP32 + tok * 416u + (colbase == 2944 ? 384 : colbase - 2048) + 4 * hi;
#pragma unroll
      for (int g = 0; g < 4; ++g) *(float4*)(Tp + 8 * g) = make_float4(v[4 * g], v[4 * g + 1], v[4 * g + 2], v[4 * g + 3]);
    } else if (colbase < 2944) {
      u16* G = B.GATE + tok * 1024u + 512 + (colbase - 2432) + 4 * hi;
#pragma unroll
      for (int g = 0; g < 4; ++g) *(uint2*)(G + 8 * g) = make_uint2(pk2(silu_f(v[4 * g]), silu_f(v[4 * g + 1])), pk2(silu_f(v[4 * g + 2]), silu_f(v[4 * g + 3])));
    } else if (colbase == 2976) {
      if (hi == 0) {
        float lf[4];
#pragma unroll
        for (int j = 0; j < 4; ++j) { const float x = v[j] + P.b_f[l * 4 + j]; lf[j] = fminf(x, 0.f) - __logf(1.f + __expf(-fabsf(x))); }
        const float4 o4 = make_float4(lf[0], lf[1], lf[2], lf[3]);
        *(float4*)(P.out + (samp ? O_SLF + (size_t)l * 512 : O_PLF + (size_t)l * 131072) + otok * 4u) = o4;
        *(float4*)(B.LOGF + tok * 4u) = o4;
      }
    }
  }
};

struct EpiQ {
  const Bufs& B;
  template <bool SW>
  DI void run(int rowbase, int colbase, const f32x16 v, int r32, int hi) const {
    const int within = colbase % 96;
    const u32 tok = (u32)rowbase + r32;
    u16* Q = B.QM + tok * 768u + colbase + 4 * hi;
    if (within < 64) {
#pragma unroll
      for (int g = 0; g < 4; ++g) *(uint2*)(Q + 8 * g) = make_uint2(pk2(v[4 * g] * MSC, v[4 * g + 1] * MSC), pk2(v[4 * g + 2] * MSC, v[4 * g + 3] * MSC));
    } else {
      const int pos = tok < NP ? (int)(tok & 4095u) : 2048 + (int)((tok - NP) & 15u);
#pragma unroll
      for (int g = 0; g < 2; ++g) {
        float o1[4], o2[4];
#pragma unroll
        for (int j = 0; j < 4; ++j) {
          float c, s; rope_cs(pos, 8 * g + 4 * hi + j, c, s);
          const float x1 = v[4 * g + j], x2 = v[4 * (g + 2) + j];
          o1[j] = (x1 * c - x2 * s) * MSC; o2[j] = (x2 * c + x1 * s) * MSC;
        }
        *(uint2*)(Q + 8 * g) = make_uint2(pk2(o1[0], o1[1]), pk2(o1[2], o1[3]));
        *(uint2*)(Q + 8 * (g + 2)) = make_uint2(pk2(o2[0], o2[1]), pk2(o2[2], o2[3]));
      }
    }
  }
};

struct EpiKV {
  const Params& P; int cache;
  template <bool SW>
  DI void run(int rowbase, int colbase, const f32x16 v, int r32, int hi) const {
    if (SW) {
      const u32 tok = (u32)rowbase + r32;
      u32 krow_; size_t base;
      if (cache) { krow_ = (tok >> 11) * T_S + (tok & 2047u); base = WS_KN_S; }
      else if (tok >= NP) { const u32 ot = tok - NP; krow_ = (ot >> 4) * T_S + 2048u + (ot & 15u); base = WS_KN_S; }
      else { krow_ = tok; base = WS_KN_P; }
      u16* Kp = (u16*)(P.ws + base) + krow_ * 512u + colbase + 4 * hi;
#pragma unroll
      for (int g = 0; g < 4; ++g) *(uint2*)(Kp + 8 * g) = make_uint2(pk2(v[4 * g], v[4 * g + 1]), pk2(v[4 * g + 2], v[4 * g + 3]));
    } else {
      const u32 c = (u32)(colbase - 512) + r32;
      const u32 rb = (u32)rowbase + 4u * hi;
#pragma unroll
      for (int g = 0; g < 4; ++g) {
        const u32 row0 = rb + 8 * g;
        u32 bb, t0, T; size_t base;
        if (cache) { bb = row0 >> 11; t0 = row0 & 2047u; T = T_S; base = WS_VM_S; }
        else if (row0 >= NP) { const u32 ot = row0 - NP; bb = ot >> 4; t0 = 2048u + (ot & 15u); T = T_S; base = WS_VM_S; }
        else { bb = row0 >> 12; t0 = row0 & 4095u; T = 4096; base = WS_VM_P; }
        *(uint2*)((u16*)(P.ws + base) + ((bb * 512u + c) * T + t0)) = make_uint2(pk2(v[4 * g], v[4 * g + 1]), pk2(v[4 * g + 2], v[4 * g + 3]));
      }
    }
  }
};

struct EpiY {
  const Bufs& B;
  template <bool SW>
  DI void run(int rowbase, int colbase, const f32x16 v, int r32, int hi) const {
    u16* Yp = B.Y + ((u32)rowbase + r32) * 1024u + colbase + 4 * hi;
#pragma unroll
    for (int g = 0; g < 4; ++g) *(uint2*)(Yp + 8 * g) = make_uint2(pk2(v[4 * g], v[4 * g + 1]), pk2(v[4 * g + 2], v[4 * g + 3]));
  }
};

template <class Epi>
DI void phase_gemm(const u16* A, int lda, const u16* Bt, int ldb, int K, int ntn, char* lds, const Epi& epi, bool vsplit) {
  const int x = blockIdx.x & 7, j = blockIdx.x >> 3, nb = gridDim.x >> 3;
  if (ntn == 24) {
    const int nmt = (x >> 2) ? 129 : 128;
    for (int q = j; q < nmt * 6; q += nb) {
      const int ml = q / 6, nl = q - ml * 6;
      const int mt = (x >> 2) * 128 + ml, nt = (x & 3) * 6 + nl;
      if (vsplit && ((nt & 6) == 4) && nt < 16) gemm_tile<Epi, false>(A, lda, Bt, ldb, K, mt * 128, nt * 128, lds, epi);
      else gemm_tile<Epi, true>(A, lda, Bt, ldb, K, mt * 128, nt * 128, lds, epi);
    }
  } else {
    const int nmt = (x == 0) ? 33 : 32;
    for (int q = j; q < nmt * ntn; q += nb) {
      const int ml = q / ntn, nl = q - ml * ntn;
      const int mt = (ml < 32) ? x * 32 + ml : 256;
      gemm_tile<Epi, true>(A, lda, Bt, ldb, K, mt * 128, nl * 128, lds, epi);
    }
  }
}

DI void phase_A2b(const Params& P, const Bufs& B, int l, char* lds) {
  constexpr int NQ = (R / 128) * 6, NKV = (R / 128) * 8, NKC = 128 * 8;
  const EpiQ eq{B}; const EpiKV ekv{P, 0}; const EpiKV ekc{P, 1};
  const u16* wq = B.wq + (size_t)l * 768 * 256; const u16* wkv = B.wkv + (size_t)l * 1024 * 128;
  for (int t = blockIdx.x; t < NQ + NKV + NKC; t += gridDim.x) {
    if (t < NQ) { const int mt = t / 6, nt = t - mt * 6; gemm_tile<EpiQ, true>(B.CQN, 256, wq, 256, 256, mt * 128, nt * 128, lds, eq); }
    else if (t < NQ + NKV) {
      const int u = t - NQ; const int mt = u >> 3, nt = u & 7;
      if (nt < 4) gemm_tile<EpiKV, true>(B.CKVN, 128, wkv, 128, 128, mt * 128, nt * 128, lds, ekv);
      else gemm_tile<EpiKV, false>(B.CKVN, 128, wkv, 128, 128, mt * 128, nt * 128, lds, ekv);
    } else {
      const int u = t - NQ - NKV; const int mt = u >> 3, nt = u & 7;
      if (nt < 4) gemm_tile<EpiKV, true>(B.CKVC, 128, wkv, 128, 128, mt * 128, nt * 128, lds, ekc);
      else gemm_tile<EpiKV, false>(B.CKVC, 128, wkv, 128, 128, mt * 128, nt * 128, lds, ekc);
    }
  }
}

DI void phase_A2a(const Params& P, const Bufs& B, int l, char* lds) {
  const int tid = otid(), lane = tid & 63, w = tid >> 6;
  if (blockIdx.x < 16) {
    const int itb = blockIdx.x; const bool sp = itb >= 8; const int b = itb & 7;
    const int per = sp ? 9 : 16, total = sp ? 2064 : 4096, TT = sp ? T_S : 4096;
    const float4* c4 = (const float4*)(P.cache_fox_logf + ((size_t)l * 8 + b) * 2048 * 4);
    const float4* n4 = (const float4*)(B.LOGF + (sp ? ((size_t)NP + b * 16) * 4 : (size_t)b * 4096 * 4));
    const float4 zz = {0.f, 0.f, 0.f, 0.f};
    float4 v0 = zz, v1 = zz, v2 = zz, v3 = zz, v4 = zz, v5 = zz, v6 = zz, v7 = zz, v8 = zz, v9 = zz, v10 = zz, v11 = zz, v12 = zz, v13 = zz, v14 = zz, v15 = zz;
    double s0 = 0, s1 = 0, s2 = 0, s3 = 0;
#define FLD(i) if (i < per) { const int t = tid * per + i; if (t < total) v##i = sp ? (t < 2048 ? c4[t] : n4[t - 2048]) : n4[t]; s0 += v##i.x; s1 += v##i.y; s2 += v##i.z; s3 += v##i.w; }
    FLD(0) FLD(1) FLD(2) FLD(3) FLD(4) FLD(5) FLD(6) FLD(7) FLD(8) FLD(9) FLD(10) FLD(11) FLD(12) FLD(13) FLD(14) FLD(15)
#undef FLD
    double e0 = s0, e1 = s1, e2 = s2, e3 = s3;
#pragma unroll
    for (int o = 1; o < 64; o <<= 1) {
      const double t0 = shfl_up_d(e0, o), t1 = shfl_up_d(e1, o), t2 = shfl_up_d(e2, o), t3 = shfl_up_d(e3, o);
      if (lane >= o) { e0 += t0; e1 += t1; e2 += t2; e3 += t3; }
    }
    double* wt = (double*)lds;
    __syncthreads();
    if (lane == 63) { wt[w * 4 + 0] = e0; wt[w * 4 + 1] = e1; wt[w * 4 + 2] = e2; wt[w * 4 + 3] = e3; }
    __syncthreads();
    double r0 = e0 - s0, r1 = e1 - s1, r2 = e2 - s2, r3 = e3 - s3;
    for (int q = 0; q < w; ++q) { r0 += wt[q * 4 + 0]; r1 += wt[q * 4 + 1]; r2 += wt[q * 4 + 2]; r3 += wt[q * 4 + 3]; }
    float* d0 = (float*)(P.ws + (sp ? WS_FS : WS_FP)) + (size_t)b * 4 * TT;
#define FST(i) if (i < per) { const int t = tid * per + i; r0 += v##i.x; r1 += v##i.y; r2 += v##i.z; r3 += v##i.w; \
      if (t < TT) { d0[t] = (float)(r0 * (double)LOG2E); d0[TT + t] = (float)(r1 * (double)LOG2E); d0[2 * TT + t] = (float)(r2 * (double)LOG2E); d0[3 * TT + t] = (float)(r3 * (double)LOG2E); } }
    FST(0) FST(1) FST(2) FST(3) FST(4) FST(5) FST(6) FST(7) FST(8) FST(9) FST(10) FST(11) FST(12) FST(13) FST(14) FST(15)
#undef FST
    __syncthreads();
  }
  for (int g = blockIdx.x * 4 + w; g < R / 4; g += gridDim.x * 4) {
    const int row0 = g * 4;
    const bool samp = row0 >= NP;
    const int orow0 = samp ? row0 - NP : row0;
    const int bb = samp ? (orow0 >> 4) : (row0 >> 12);
    const int t0 = samp ? 2048 + (orow0 & 15) : (row0 & 4095);
    const int T = samp ? T_S : 4096;
    const size_t km0 = samp ? (size_t)bb * T_S + t0 : (size_t)row0;
    u16* KPE = (u16*)(P.ws + (samp ? WS_KPE_S : WS_KPE_P));
    const float4 gq = ((const float4*)(P.g_q_a + l * 256))[lane];
#pragma unroll
    for (int j = 0; j < 4; ++j) {
      const float4 v = *(const float4*)(B.TMP32 + (size_t)(row0 + j) * 416 + lane * 4);
      const float ss = wave_sum(v.x * v.x + v.y * v.y + v.z * v.z + v.w * v.w);
      const float rs = rsqrtf(ss * (1.f / 256.f) + EPSN);
      uint2 o = {pk2(v.x * rs * gq.x, v.y * rs * gq.y), pk2(v.z * rs * gq.z, v.w * rs * gq.w)};
      *(uint2*)(B.CQN + (size_t)(row0 + j) * 256 + lane * 4) = o;
    }
    const float2 gk = ((const float2*)(P.g_kv_a + l * 128))[lane];
    float* ockv = P.out + (samp ? O_SCKV + (size_t)l * 16384 : O_PCKV + (size_t)l * 4194304);
    float n0[4], n1[4];
#pragma unroll
    for (int j = 0; j < 4; ++j) {
      const float2 v = *(const float2*)(B.TMP32 + (size_t)(row0 + j) * 416 + 256 + lane * 2);
      const float ss = wave_sum(v.x * v.x + v.y * v.y);
      const float rs = rsqrtf(ss * (1.f / 128.f) + EPSN);
      n0[j] = v.x * rs * gk.x; n1[j] = v.y * rs * gk.y;
      float2 o = {n0[j], n1[j]};
      *(float2*)(ockv + (size_t)(orow0 + j) * 128 + lane * 2) = o;
      *(u32*)(B.CKVN + (size_t)(row0 + j) * 128 + lane * 2) = pk2(n0[j], n1[j]);
    }
    {
      const int j = lane >> 4, i = lane & 15;
      const float x1 = B.TMP32[(size_t)(row0 + j) * 416 + 384 + i], x2 = B.TMP32[(size_t)(row0 + j) * 416 + 400 + i];
      float c, s; rope_cs(t0 + j, i, c, s);
      const float o1 = x1 * c - x2 * s, o2 = x2 * c + x1 * s;
      float* okpe = P.out + (samp ? O_SKPE + (size_t)l * 4096 : O_PKPE + (size_t)l * 1048576);
      okpe[(size_t)(orow0 + j) * 32 + i] = o1; okpe[(size_t)(orow0 + j) * 32 + 16 + i] = o2;
      KPE[(km0 + j) * 32 + i] = bf1(o1); KPE[(km0 + j) * 32 + 16 + i] = bf1(o2);
    }
  }
  const size_t gtid = (size_t)blockIdx.x * 256 + tid, gsz = (size_t)gridDim.x * 256;
  for (size_t i = gtid; i < (size_t)2 * 8 * 2048 * 32; i += gsz) {
    const int which = (int)(i >> 19); const size_t r = i & 524287; const int cc = (int)(r & 31); const int bt = (int)(r >> 5);
    const int b = bt >> 11, t = bt & 2047;
    const float* src = (which ? P.cache_sb_k : P.cache_fox_k) + (((size_t)l * 8 + b) * 2048 + t) * 256 + cc * 8;
    const float4 v0 = ((const float4*)src)[0], v1 = ((const float4*)src)[1];
    uint4 o = {pk2(v0.x, v0.y), pk2(v0.z, v0.w), pk2(v1.x, v1.y), pk2(v1.z, v1.w)};
    *(uint4*)((u16*)(P.ws + (which ? WS_KS_S : WS_KF_S)) + ((size_t)b * T_S + t) * 256 + cc * 8) = o;
  }
  for (size_t i = gtid; i < (size_t)8 * 2048 * 20; i += gsz) {
    const int cc = (int)(i % 20); const int bt = (int)(i / 20); const int b = bt >> 11, t = bt & 2047;
    const float* srcp = cc < 16 ? P.cache_ckv + (((size_t)l * 8 + b) * 2048 + t) * 128 + cc * 8 : P.cache_kpe + (((size_t)l * 8 + b) * 2048 + t) * 32 + (cc - 16) * 8;
    const float4 v0 = ((const float4*)srcp)[0], v1 = ((const float4*)srcp)[1];
    uint4 o = {pk2(v0.x, v0.y), pk2(v0.z, v0.w), pk2(v1.x, v1.y), pk2(v1.z, v1.w)};
    if (cc < 16) *(uint4*)(B.CKVC + (size_t)bt * 128 + cc * 8) = o;
    else *(uint4*)(B.KPE_S + ((size_t)b * T_S + t) * 32 + (cc - 16) * 8) = o;
  }
  for (size_t i = gtid; i < (size_t)2 * 8 * 256 * 256; i += gsz) {
    const int which = (int)(i >> 19); const size_t r = i & 524287; const int hd = (int)(r & 255); const int t8 = (int)((r >> 8) & 255); const int b = (int)(r >> 16);
    const float* src = (which ? P.cache_sb_v : P.cache_fox_v) + (((size_t)l * 8 + b) * 2048 + t8 * 8) * 256 + hd;
    float v[8];
#pragma unroll
    for (int j = 0; j < 8; ++j) v[j] = src[(size_t)j * 256];
    uint4 o = {pk2(v[0], v[1]), pk2(v[2], v[3]), pk2(v[4], v[5]), pk2(v[6], v[7])};
    *(uint4*)((u16*)(P.ws + (which ? WS_VST_S : WS_VFT_S)) + ((size_t)b * 256 + hd) * T_S + t8 * 8) = o;
  }
  const uint4 z4 = {0u, 0u, 0u, 0u};
  for (size_t i = gtid; i < (size_t)8 * 48 * 32; i += gsz) {
    const int cc = (int)(i & 31); const int r = (int)((i >> 5) % 48); const int b = (int)(i / (48 * 32));
    *(uint4*)(B.KF_S + ((size_t)b * T_S + 2064 + r) * 256 + cc * 8) = z4;
    *(uint4*)(B.KS_S + ((size_t)b * T_S + 2064 + r) * 256 + cc * 8) = z4;
  }
  for (size_t i = gtid; i < (size_t)8 * 48 * 68; i += gsz) {
    const int cc = (int)(i % 68); const int r = (int)((i / 68) % 48); const int b = (int)(i / (48 * 68));
    if (cc < 64) *(uint4*)(B.KN_S + ((size_t)b * T_S + 2064 + r) * 512 + cc * 8) = z4;
    else *(uint4*)(B.KPE_S + ((size_t)b * T_S + 2064 + r) * 32 + (cc - 64) * 8) = z4;
  }
  for (size_t i = gtid; i < (size_t)8 * 512 * 6; i += gsz) {
    const int cc = (int)(i % 6); const int rr = (int)(i / 6);
    *(uint4*)(B.VM_S + (size_t)rr * T_S + 2064 + cc * 8) = z4;
    if (rr < 8 * 256) { *(uint4*)(B.VFT_S + (size_t)rr * T_S + 2064 + cc * 8) = z4; *(uint4*)(B.VST_S + (size_t)rr * T_S + 2064 + cc * 8) = z4; }
  }
}

typedef short v4i16_t __attribute__((ext_vector_type(4)));
DI uint2 lds_tr16(const u16* p) {
  const v4i16_t r = __builtin_amdgcn_ds_read_tr16_b64_v4i16((LAS v4i16_t*)(unsigned)(uintptr_t)p);
  return __builtin_bit_cast(uint2, r);
}
template <int TYPE>
DI void attn_item(const Params& P, const Bufs& B, int l, bool samp, int b, int hh, int qt, char* lds) {
  constexpr int DK = (TYPE == 2) ? 96 : 64, DV = 64;
  constexpr int KP = DK + 8, VP = 68;
  constexpr int NKC = 64 * DK / 8 / 256;
  constexpr int NVC = 2;
  constexpr int NDT = DV / 32;
  constexpr int NST = DK / 16;
  constexpr int STG = 64 * KP * 2 + 64 * VP * 2 + 256;
  const int tid = otid(), lane = tid & 63, w = tid >> 6, r32 = lane & 31, hi = lane >> 5;
  int head, qrow0, nvalid, qpos0, ntiles; bool active;
  if (!samp) { head = hh; qrow0 = b * 4096 + qt * 128 + w * 32; nvalid = 32; qpos0 = qt * 128 + w * 32; ntiles = 2 * qt + 2; active = true; }
  else {
    head = hh; active = (w == 0);
    qrow0 = NP + b * 16; nvalid = 16; qpos0 = 2048; ntiles = 33;
  }
  const int qi = r32 < nvalid ? r32 : nvalid - 1;
  const int qrow = qrow0 + qi, qpos = qpos0 + qi;
  const bool lane_valid = active && (r32 < nvalid);
  const int qlast = qpos0 + nvalid - 1;
  const int klim = samp ? 2064 : ((qpos0 >> 6) + 1) * 64;
  const u16* Kg; const u16* Kg2 = nullptr; const u16* Vg = nullptr; int kpitch, vpitch; const float* Fg = nullptr;
  {
    const int TT = samp ? T_S : 4096;
    vpitch = TT;
    if (TYPE == 2) {
      kpitch = 512;
      Kg = (const u16*)(P.ws + (samp ? WS_KN_S : WS_KN_P)) + (size_t)b * TT * 512 + head * 64;
      Kg2 = (const u16*)(P.ws + (samp ? WS_KPE_S : WS_KPE_P)) + (size_t)b * TT * 32;
      Vg = (const u16*)(P.ws + (samp ? WS_VM_S : WS_VM_P)) + ((size_t)(b * 8 + head) * 64) * TT;
    } else {
      kpitch = 256;
      Kg = (const u16*)(P.ws + (TYPE == 0 ? (samp ? WS_KF_S : WS_KF_P) : (samp ? WS_KS_S : WS_KS_P))) + (size_t)b * TT * 256 + head * 64;
      Vg = (const u16*)(P.ws + (TYPE == 0 ? (samp ? WS_VFT_S : WS_VFT_P) : (samp ? WS_VST_S : WS_VST_P))) + ((size_t)(b * 4 + head) * 64) * TT;
      Fg = (const float*)(P.ws + (samp ? WS_FS : WS_FP)) + (size_t)(b * 4 + head) * TT;
    }
  }
  const bf16x8 zb = {0, 0, 0, 0, 0, 0, 0, 0};
  bf16x8 qf0 = zb, qf1 = zb, qf2 = zb, qf3 = zb, qf4 = zb, qf5 = zb, qf6 = zb, qf7 = zb, qf8 = zb, qf9 = zb;
  {
    const u16* Qp = TYPE == 0 ? B.QF + (size_t)qrow * 256 + head * 64 : TYPE == 1 ? B.QS + (size_t)qrow * 256 + head * 64 : B.QM + (size_t)qrow * 768 + head * 96;
#define QLD(s) if (s < NST) qf##s = *(const bf16x8*)(Qp + s * 16 + hi * 8);
    QLD(0) QLD(1) QLD(2) QLD(3) QLD(4) QLD(5) QLD(6) QLD(7) QLD(8) QLD(9)
#undef QLD
  }
  float zmax = INFINITY;
  if (TYPE == 0 && !samp) {
    const float4 km = *(const float4*)((const float*)(P.ws + WS_KMAX) + ((l * 8 + b) * 4 + head) * 4);
    float qn = 0.f;
#define QSQ(s) _Pragma("unroll") for (int j = 0; j < 8; ++j) { const float x = __uint_as_float(((u32)(u16)qf##s[j]) << 16); qn += x * x; }
    QSQ(0) QSQ(1) QSQ(2) QSQ(3)
#undef QSQ
    qn = halves_sum(qn);
    zmax = sqrtf(qn * (km.x + km.y + km.z + km.w)) * 1.02f + 1e-3f;
  }
  f32x16 zf;
#pragma unroll
  for (int i = 0; i < 16; ++i) zf[i] = 0.f;
  f32x16 O0 = zf, O1 = zf, O2 = zf, O3 = zf;
  float m = (TYPE == 2) ? 0.f : -INFINITY, lsum = 0.f, carry = 1.f;
  f32x16 NM = zf;
  bool first = true;
  bool wdead = !active;
  volatile int* dflags = (volatile int*)(lds + 2 * STG);
  const uint4 z4 = {0u, 0u, 0u, 0u};
  uint4 rak0 = z4, rak1 = z4, rak2 = z4, rav0 = z4, rav1 = z4; float raf_ = 0.f;
  uint4 rbk0 = z4, rbk1 = z4, rbk2 = z4, rbv0 = z4, rbv1 = z4; float rbf_ = 0.f;
#define KLD(S, i) if (i < NKC) { const int c_ = tid + 256 * i; const int row_ = (DK == 64) ? (c_ >> 3) : (c_ / 12); const int cc_ = (DK == 64) ? (c_ & 7) : (c_ - row_ * 12); \
    S##k##i = (DK == 64 || cc_ < 8) ? *(const uint4*)(Kg + (size_t)(k0_ + row_) * kpitch + cc_ * 8) : *(const uint4*)(Kg2 + (size_t)(k0_ + row_) * 32 + (cc_ - 8) * 8); }
#define VLD(S, i) { const int c_ = tid + 256 * i; S##v##i = *(const uint4*)(Vg + (size_t)(c_ >> 3) * vpitch + k0_ + (c_ & 7) * 8); }
#define ATT_PREFETCH(S, it_) { const int k0_ = ((TYPE != 2) ? ntiles - 1 - (it_) : (it_)) * 64; KLD(S, 0) KLD(S, 1) KLD(S, 2) VLD(S, 0) VLD(S, 1) if (TYPE == 0 && tid < 64) S##f_ = Fg[k0_ + tid]; }
#define KST(S, i) if (i < NKC) { const int c_ = tid + 256 * i; const int row_ = (DK == 64) ? (c_ >> 3) : (c_ / 12); const int cc_ = (DK == 64) ? (c_ & 7) : (c_ - row_ * 12); *(uint4*)(KsW + row_ * KP + cc_ * 8) = S##k##i; }
#define VST(S, i) { const int c_ = tid + 256 * i; u16* vd_ = VsW + (c_ >> 3) * VP + (c_ & 7) * 8; *(uint2*)vd_ = make_uint2(S##v##i.x, S##v##i.y); *(uint2*)(vd_ + 4) = make_uint2(S##v##i.z, S##v##i.w); }
#define ATT_STORE(S, st_) { u16* KsW = (u16*)(lds + (st_) * STG); u16* VsW = KsW + 64 * KP; float* FsW = (float*)(VsW + 64 * VP); \
    KST(S, 0) KST(S, 1) KST(S, 2) VST(S, 0) VST(S, 1) if (TYPE == 0 && tid < 64) FsW[tid] = S##f_; }
  auto tile_compute = [&](const int cur, const int it) __attribute__((always_inline)) {
    const int k0 = ((TYPE != 2) ? ntiles - 1 - it : it) * 64;
    const u16* Ks = (const u16*)(lds + cur * STG); const u16* Vs = Ks + 64 * KP; const float* Fs = (const float*)(Vs + 64 * VP);
    if (TYPE == 0 && !wdead) {
      const float bound = zmax - Fs[63];
      wdead = !__any(bound - m > -130.f);
    }
    const bool doit = active && (TYPE == 0 ? (!wdead && k0 <= qlast) : TYPE == 1 ? (!wdead && k0 < qlast) : (k0 < klim));
    if (doit) {
      f32x16 S0 = (TYPE == 2) ? NM : zf, S1 = (TYPE == 2) ? NM : zf;
      bool allzero = false;
#define SBAR __builtin_amdgcn_sched_barrier(0);
#define RD(s) bf16x8 ka##s = zb, kb##s = zb, qq##s = qf##s; if (s < NST) { ka##s = *(const bf16x8*)(Ks + r32 * KP + s * 16 + hi * 8); kb##s = *(const bf16x8*)(Ks + (32 + r32) * KP + s * 16 + hi * 8); \
                }
#define MM(s) if (s < NST) { S0 = MFMA(ka##s, qq##s, S0); S1 = MFMA(kb##s, qq##s, S1); }
      RD(0) RD(1) SBAR RD(2) SBAR MM(0) SBAR RD(3) SBAR MM(1) SBAR RD(4) SBAR MM(2) SBAR RD(5) SBAR MM(3) SBAR RD(6) SBAR MM(4) SBAR
      RD(7) SBAR MM(5) SBAR RD(8) SBAR MM(6) SBAR RD(9) SBAR MM(7) SBAR MM(8) SBAR MM(9) SBAR
#undef RD
#undef MM
      if (TYPE == 1) {
        f32x16 R0, R1;
        const bool need_mask = (k0 + 63 >= qpos0);
#pragma unroll
        for (int i = 0; i < 16; ++i) {
          const float e0 = ex2(fminf(S0[i], 60.f)), e1 = ex2(fminf(S1[i], 60.f));
          const float r0 = __builtin_amdgcn_rcpf(1.f + e0), r1 = __builtin_amdgcn_rcpf(1.f + e1);
          R0[i] = r0; R1[i] = r1; S0[i] = e0 * r0; S1[i] = e1 * r1;
        }
        if (need_mask) {
#pragma unroll
          for (int i = 0; i < 16; ++i) {
            const int key = k0 + crow(i, hi);
            if (!(key < qpos)) { R0[i] = 1.f; S0[i] = 0.f; }
            if (!(key + 32 < qpos)) { R1[i] = 1.f; S1[i] = 0.f; }
          }
        }
        float Rr = carry;
#define SBG(RV, SV, g) { \
          const float gown = (RV[4 * g] * RV[4 * g + 1]) * (RV[4 * g + 2] * RV[4 * g + 3]); \
          const float goth = __shfl_xor(gown, 32); \
          float sfx = hi ? Rr : Rr * goth; \
          SV[4 * g + 3] *= sfx; sfx *= RV[4 * g + 3]; \
          SV[4 * g + 2] *= sfx; sfx *= RV[4 * g + 2]; \
          SV[4 * g + 1] *= sfx; sfx *= RV[4 * g + 1]; \
          SV[4 * g] *= sfx; \
          Rr *= gown * goth; }
        SBG(R1, S1, 3) SBG(R1, S1, 2) SBG(R1, S1, 1) SBG(R1, S1, 0)
        SBG(R0, S0, 3) SBG(R0, S0, 2) SBG(R0, S0, 1) SBG(R0, S0, 0)
#undef SBG
        carry = Rr;
        wdead = !__any(carry != 0.f);
      } else {
        if (TYPE == 0) {
#pragma unroll
          for (int g = 0; g < 4; ++g) {
            const float4 f0 = *(const float4*)(Fs + 8 * g + 4 * hi);
            const float4 f1 = *(const float4*)(Fs + 32 + 8 * g + 4 * hi);
            S0[4 * g] -= f0.x; S0[4 * g + 1] -= f0.y; S0[4 * g + 2] -= f0.z; S0[4 * g + 3] -= f0.w;
            S1[4 * g] -= f1.x; S1[4 * g + 1] -= f1.y; S1[4 * g + 2] -= f1.z; S1[4 * g + 3] -= f1.w;
          }
          if (k0 + 63 > qpos0) {
#pragma unroll
            for (int i = 0; i < 16; ++i) {
              const int key = k0 + crow(i, hi);
              if (key > qpos) S0[i] = -INFINITY;
              if (key + 32 > qpos) S1[i] = -INFINITY;
            }
          }
        } else {
          if (k0 + 64 > klim) {
#pragma unroll
            for (int i = 0; i < 16; ++i) {
              const int key = k0 + crow(i, hi);
              if (key >= klim) S0[i] = -INFINITY;
              if (key + 32 >= klim) S1[i] = -INFINITY;
            }
          }
        }
        float mx = S0[0];
#pragma unroll
        for (int i = 1; i < 16; ++i) mx = fmaxf(mx, S0[i]);
#pragma unroll
        for (int i = 0; i < 16; ++i) mx = fmaxf(mx, S1[i]);
        mx = halves_max(mx);
        if (TYPE == 2) {
          if (first || __any(mx > 8.f)) {
            const float dm = first ? mx : fmaxf(mx, 0.f);
            if (!first) {
              const float alpha = ex2(-dm);
              lsum *= alpha;
#pragma unroll
              for (int i = 0; i < 16; ++i) { O0[i] *= alpha; O1[i] *= alpha; }
            }
            m += dm;
#pragma unroll
            for (int i = 0; i < 16; ++i) { NM[i] = -m; S0[i] -= dm; S1[i] -= dm; }
            first = false;
          }
          float ps = 0.f;
#pragma unroll
          for (int i = 0; i < 16; ++i) { S0[i] = ex2(S0[i]); S1[i] = ex2(S1[i]); ps += S0[i] + S1[i]; }
          lsum += ps;
        } else {
        if (TYPE == 0) allzero = !__any(mx - m > -130.f);
        if (__any(mx > m + 8.f)) {
          const float mnew = fmaxf(m, mx);
          const float alpha = ex2(m - mnew);
          m = mnew;
          lsum *= alpha;
#pragma unroll
          for (int i = 0; i < 16; ++i) { O0[i] *= alpha; O1[i] *= alpha; if (NDT > 2) { O2[i] *= alpha; O3[i] *= alpha; } }
        }
        if (!allzero) {
          float ps = 0.f;
#pragma unroll
          for (int i = 0; i < 16; ++i) { S0[i] = ex2(S0[i] - m); S1[i] = ex2(S1[i] - m); ps += S0[i] + S1[i]; }
          lsum += ps;
        }
        }
      }
      if (!allzero) {
      const bf16x8 pf0 = __builtin_bit_cast(bf16x8, make_uint4(pk2(S0[0], S0[1]), pk2(S0[2], S0[3]), pk2(S0[4], S0[5]), pk2(S0[6], S0[7])));
      const bf16x8 pf1 = __builtin_bit_cast(bf16x8, make_uint4(pk2(S0[8], S0[9]), pk2(S0[10], S0[11]), pk2(S0[12], S0[13]), pk2(S0[14], S0[15])));
      const bf16x8 pf2 = __builtin_bit_cast(bf16x8, make_uint4(pk2(S1[0], S1[1]), pk2(S1[2], S1[3]), pk2(S1[4], S1[5]), pk2(S1[6], S1[7])));
      const bf16x8 pf3 = __builtin_bit_cast(bf16x8, make_uint4(pk2(S1[8], S1[9]), pk2(S1[10], S1[11]), pk2(S1[12], S1[13]), pk2(S1[14], S1[15])));
      const u16* vbase = Vs + r32 * VP + 4 * hi;
#define VRD(d, sp) bf16x8 vf##d##sp = zb; if (d < NDT) { const uint2 lo = *(const uint2*)(vbase + d * 32 * VP + 16 * sp); const uint2 h8 = *(const uint2*)(vbase + d * 32 * VP + 16 * sp + 8); \
        vf##d##sp = __builtin_bit_cast(bf16x8, make_uint4(lo.x, lo.y, h8.x, h8.y)); }
#define VMM(d, sp) if (d < NDT) { O##d = MFMA(vf##d##sp, pf##sp, O##d); }
      VRD(0, 0) VRD(1, 0) VRD(0, 1) SBAR VRD(1, 1) SBAR VMM(0, 0) SBAR VRD(0, 2) SBAR VMM(1, 0) SBAR VRD(1, 2) SBAR VMM(0, 1) SBAR VRD(0, 3) SBAR VMM(1, 1) SBAR VRD(1, 3) SBAR
      VMM(0, 2) SBAR VRD(2, 0) SBAR VMM(1, 2) SBAR VRD(3, 0) SBAR VMM(0, 3) SBAR VRD(2, 1) SBAR VMM(1, 3) SBAR VRD(3, 1) SBAR
      VMM(2, 0) SBAR VRD(2, 2) SBAR VMM(3, 0) SBAR VRD(3, 2) SBAR VMM(2, 1) SBAR VRD(2, 3) SBAR VMM(3, 1) SBAR VRD(3, 3) SBAR
      VMM(2, 2) SBAR VMM(3, 2) SBAR VMM(2, 3) SBAR VMM(3, 3) SBAR
#undef VRD
#undef VMM
#undef SBAR
      }
    }
  };
  ATT_PREFETCH(ra, 0)
  if (ntiles > 1) { ATT_PREFETCH(rb, 1) }
  ATT_STORE(ra, 0)
  __syncthreads();
  for (int it = 0; it < ntiles; it += 2) {
    if (it + 2 < ntiles) { ATT_PREFETCH(ra, it + 2) }
    __builtin_amdgcn_sched_barrier(0);
    tile_compute(0, it);
    if (it + 1 < ntiles) { ATT_STORE(rb, 1) }
    if (TYPE != 2 && lane == 0) dflags[w] = wdead ? 1 : 0;
    __syncthreads();
    if (TYPE != 2) { if (dflags[0] & dflags[1] & dflags[2] & dflags[3]) break; }
    if (it + 1 >= ntiles) break;
    if (it + 3 < ntiles) { ATT_PREFETCH(rb, it + 3) }
    __builtin_amdgcn_sched_barrier(0);
    tile_compute(1, it + 1);
    if (it + 2 < ntiles) { ATT_STORE(ra, 0) }
    if (TYPE != 2 && lane == 0) dflags[4 + w] = wdead ? 1 : 0;
    __syncthreads();
    if (TYPE != 2) { if (dflags[4] & dflags[5] & dflags[6] & dflags[7]) break; }
  }
#undef ATT_PREFETCH
#undef ATT_STORE
#undef KLD
#undef VLD
#undef KST
#undef VST
  if (active) {
    float inv = 1.f;
    if (TYPE != 1) { const float lt = halves_sum(lsum); inv = 1.f / lt; }
    const u32 orow = (u32)qrow * 1024u;
    {
      const int goff = (TYPE == 0 ? 0 : TYPE == 1 ? 256 : 512) + head * 64;
#define OEP(d) _Pragma("unroll") for (int g = 0; g < 4; ++g) { \
          const int dd = d * 32 + 8 * g + 4 * hi; \
          const uint2 gv = *(const uint2*)(B.GATE + orow + goff + dd); \
          const float g0 = __uint_as_float(gv.x << 16), g1 = __uint_as_float(gv.x & 0xffff0000u), g2 = __uint_as_float(gv.y << 16), g3 = __uint_as_float(gv.y & 0xffff0000u); \
          uint2 o = {pk2(O##d[4 * g] * inv * g0, O##d[4 * g + 1] * inv * g1), pk2(O##d[4 * g + 2] * inv * g2, O##d[4 * g + 3] * inv * g3)}; \
          if (lane_valid) *(uint2*)(B.H + orow + goff + dd) = o; }
      OEP(0) OEP(1)
#undef OEP
    }
  }
}

constexpr int N_Q_ITEMS = 16 + 512;
DI void phase_attn(const Params& P, const Bufs& B, int ci, int l, char* lds, int* s_item, int xcc, int only_type = -1) {
  for (int qx = 0; qx < 8; ++qx) {
    const int q = (xcc + qx) & 7;
    while (true) {
      __syncthreads();
      if (threadIdx.x == 0) *s_item = (int)atomicAdd(B.ctr + ci * 8 + q, 1u);
      __syncthreads();
      const int it = *s_item;
      if (it >= N_Q_ITEMS) break;
      bool samp; int type, hh, qt; const int b = q;
      if (it < 16) {
        samp = true; qt = 0;
        if (it < 8) { type = 2; hh = it; } else if (it < 12) { type = 0; hh = it - 8; } else { type = 1; hh = it - 12; }
      } else {
        const int j = it - 16;
        samp = false;
        qt = 31 - (j >> 4); const int k16 = j & 15;
        if (k16 & 1) { type = 2; hh = k16 >> 1; } else if (k16 & 2) { type = 0; hh = k16 >> 2; } else { type = 1; hh = k16 >> 2; }
      }
      if (only_type >= 0 && type != only_type) continue;
      if (type == 0) attn_item<0>(P, B, l, samp, b, hh, qt, lds);
      else if (type == 1) attn_item<1>(P, B, l, samp, b, hh, qt, lds);
      else attn_item<2>(P, B, l, samp, b, hh, qt, lds);
    }
  }
}

__global__ void __launch_bounds__(256, 2) fwd_megakernel(Params P) {
  cg::grid_group grid = cg::this_grid();
  __shared__ __attribute__((aligned(16))) char lds[73728];
  __shared__ int s_item;
  __shared__ uint4 xb_words;
  if (threadIdx.x == 0) xb_words = make_uint4(0u, 0u, 0u, 0u);
  __syncthreads();
  const XcdBarrier xb = xcd_barrier_post((unsigned*)(P.ws + WS_BAR), (volatile LAS unsigned*)&xb_words);
  if (P.ws == nullptr) grid.sync();
  const Bufs B = make_bufs(P.ws);
  phase_prep(P, B);
  xcd_barrier(xb);
  phase_mod(P, B, lds);
  xcd_barrier(xb);
  phase_D(P, B, 0);
  xcd_barrier(xb);
#pragma unroll 1
  for (int l = 0; l < 2; ++l) {
#pragma unroll 1
    for (int rep = 0; rep <= REP_GEMM; ++rep) { EpiIn e{P, B, l}; phase_gemm(B.H, 1024, B.win + (size_t)l * 3072 * 1024, 1024, 1024, 24, lds, e, true); }
    xcd_barrier(xb);
    phase_A2a(P, B, l, lds);
    xcd_barrier(xb);
#pragma unroll 1
    for (int rep = 0; rep <= REP_GEMM; ++rep) phase_A2b(P, B, l, lds);
    xcd_barrier(xb);
#pragma unroll 1
    for (int rep = 0; rep <= REP_ATTN; ++rep) { phase_attn(P, B, l + 2 * rep, l, lds, &s_item, (int)xb.x, rep ? 2 : -1); if (rep < REP_ATTN) xcd_barrier(xb); }
    xcd_barrier(xb);
#pragma unroll 1
    for (int rep = 0; rep <= REP_GEMM; ++rep) { EpiY e{B}; phase_gemm(B.H, 1024, B.wout + (size_t)l * 1024 * 1024, 1024, 1024, 8, lds, e, false); }
    xcd_barrier(xb);
    phase_D(P, B, l + 1);
    if (l == 0) xcd_barrier(xb);
  }
}

extern "C" void kernel_launch(void* const* d_in, const int* in_sizes, int n_in,
                              void* d_out, int out_size, void* d_ws, size_t ws_size,
                              hipStream_t stream) {
  static int grid_blocks = 0;
  if (!grid_blocks) {
    int dev = 0, cus = 0, per_cu = 0;
    (void)hipGetDevice(&dev);
    (void)hipDeviceGetAttribute(&cus, hipDeviceAttributeMultiprocessorCount, dev);
    (void)hipOccupancyMaxActiveBlocksPerMultiprocessor(&per_cu, fwd_megakernel, 256, 0);
    if (per_cu > 2) per_cu = 2;
    if (per_cu < 1) per_cu = 1;
    grid_blocks = cus * per_cu;
    if (ws_size < WS_END) fprintf(stderr, "workspace too small: %zu < %zu\n", ws_size, (size_t)WS_END);
  }
  Params p{};
  const float** pp = (const float**)&p;
  for (int i = 0; i < 23; ++i) pp[i] = (const float*)d_in[i];
  p.out = (float*)d_out;
  p.ws = (unsigned char*)d_ws;
  (void)hipMemsetAsync((char*)d_ws + WS_CTR, 0, 256 + 16384, stream);
  void* args[] = {&p};
  hipError_t e = hipLaunchCooperativeKernel((void*)fwd_megakernel, dim3(grid_blocks), dim3(256), args, 0, stream);
  if (e != hipSuccess) fprintf(stderr, "cooperative launch failed: %s (grid %d)\n", hipGetErrorString(e), grid_blocks);
}
```

```cpp
#include <hip/hip_runtime.h>
#include <hip/hip_cooperative_groups.h>
#include <cstdio>
#include <cstdint>
namespace cg = cooperative_groups;
#define REP_ATTN 0
#define REP_GEMM 0

typedef unsigned short u16;
typedef unsigned int u32;
using bf16x8 = __attribute__((ext_vector_type(8))) short;
using f32x16 = __attribute__((ext_vector_type(16))) float;
typedef __bf16 bf16x2_t __attribute__((ext_vector_type(2)));
typedef float f32x2_t __attribute__((ext_vector_type(2)));
#define DI __device__ __forceinline__
#define MFMA(a, b, c) __builtin_amdgcn_mfma_f32_32x32x16_bf16((a), (b), (c), 0, 0, 0)

constexpr int NP = 32768, NSM = 128, R = NP + NSM;
constexpr int T_S = 2112;
constexpr float LOG2E = 1.4426950408889634f;
constexpr float QSC = 0.125f * LOG2E;
constexpr float MSC = 0.10206207261596575f * LOG2E;
constexpr float EPSN = 1e-6f;

constexpr size_t O_Y = 0;
constexpr size_t O_PFK = (size_t)R * 1024;
constexpr size_t O_PFV = O_PFK + 16777216;
constexpr size_t O_PLF = O_PFV + 16777216;
constexpr size_t O_PSK = O_PLF + 262144;
constexpr size_t O_PSV = O_PSK + 16777216;
constexpr size_t O_PCKV = O_PSV + 16777216;
constexpr size_t O_PKPE = O_PCKV + 8388608;
constexpr size_t O_SFK = O_PKPE + 2097152;
constexpr size_t O_SFV = O_SFK + 65536;
constexpr size_t O_SLF = O_SFV + 65536;
constexpr size_t O_SSK = O_SLF + 1024;
constexpr size_t O_SSV = O_SSK + 65536;
constexpr size_t O_SCKV = O_SSV + 65536;
constexpr size_t O_SKPE = O_SCKV + 32768;

constexpr size_t al256(size_t x) { return (x + 255) & ~(size_t)255; }
constexpr size_t WS_CTR = 0;
constexpr size_t WS_BAR = 256;
constexpr size_t WS_KMAX = 256 + 14336;
constexpr size_t WS_SILUC = 256 + 16384;
constexpr size_t WS_MOD = WS_SILUC + 16 * 1024 * 4;
constexpr size_t WS_WIN = WS_MOD + 2 * 16 * 3072 * 4;
constexpr size_t WS_WQ = WS_WIN + (size_t)2 * 3072 * 1024 * 2;
constexpr size_t WS_WKV = WS_WQ + (size_t)2 * 768 * 256 * 2;
constexpr size_t WS_WOUT = WS_WKV + (size_t)2 * 1024 * 128 * 2;
constexpr size_t WS_H = WS_WOUT + (size_t)2 * 1024 * 1024 * 2;
constexpr size_t WS_GATE = WS_H + (size_t)R * 1024 * 2;
constexpr size_t WS_QM = WS_GATE + (size_t)R * 1024 * 2;
constexpr size_t WS_TMP32 = WS_QM;
constexpr size_t WS_CQN = WS_QM + (size_t)R * 1024 * 2;
constexpr size_t WS_QF = WS_CQN + (size_t)R * 256 * 2;
constexpr size_t WS_QS = WS_QF + (size_t)R * 256 * 2;
constexpr size_t WS_KF_P = WS_QS + (size_t)R * 256 * 2;
constexpr size_t WS_KS_P = WS_KF_P + (size_t)NP * 256 * 2;
constexpr size_t WS_VFT_P = WS_KS_P + (size_t)NP * 256 * 2;
constexpr size_t WS_VST_P = WS_VFT_P + (size_t)NP * 256 * 2;
constexpr size_t WS_KN_P = WS_VST_P + (size_t)NP * 256 * 2;
constexpr size_t WS_KPE_P = WS_KN_P + (size_t)NP * 512 * 2;
constexpr size_t WS_VM_P = WS_KPE_P + (size_t)NP * 32 * 2;
constexpr size_t WS_CKVN = WS_VM_P + (size_t)NP * 512 * 2;
constexpr size_t WS_KF_S = WS_CKVN + (size_t)R * 128 * 2;
constexpr size_t WS_KS_S = WS_KF_S + (size_t)8 * T_S * 256 * 2;
constexpr size_t WS_VFT_S = WS_KS_S + (size_t)8 * T_S * 256 * 2;
constexpr size_t WS_VST_S = WS_VFT_S + (size_t)8 * T_S * 256 * 2;
constexpr size_t WS_KN_S = WS_VST_S + (size_t)8 * T_S * 256 * 2;
constexpr size_t WS_KPE_S = WS_KN_S + (size_t)8 * T_S * 512 * 2;
constexpr size_t WS_VM_S = WS_KPE_S + (size_t)8 * T_S * 32 * 2;
constexpr size_t WS_CKVC = WS_VM_S + (size_t)8 * T_S * 512 * 2;
constexpr size_t WS_LOGF = WS_CKVC + (size_t)8 * 2048 * 128 * 2;
constexpr size_t WS_FP = WS_LOGF + (size_t)R * 4 * 4;
constexpr size_t WS_FS = WS_FP + (size_t)8 * 4 * 4096 * 4;
constexpr size_t WS_END = WS_FS + (size_t)8 * 4 * T_S * 4;
static_assert((size_t)R * 416 * 4 <= (size_t)R * 1024 * 2 && (size_t)R * 768 * 2 <= (size_t)R * 1024 * 2, "aliases must fit");
static_assert(WS_END < (size_t)530 * 1000 * 1000, "workspace too large");

struct Params {
  const float* x_prompt; const float* x_sample; const float* c_prompt; const float* c_sample;
  const float* cache_fox_k; const float* cache_fox_v; const float* cache_fox_logf;
  const float* cache_sb_k; const float* cache_sb_v; const float* cache_ckv; const float* cache_kpe;
  const float* g_pre; const float* g_post; const float* w_ada; const float* b_ada; const float* w_in;
  const float* b_f; const float* g_q_a; const float* w_uq; const float* g_kv_a; const float* w_uk;
  const float* w_uv; const float* w_out;
  float* out;
  unsigned char* ws;
};

DI u32 pk2(float a, float b) { f32x2_t v = {a, b}; bf16x2_t r = __builtin_convertvector(v, bf16x2_t); return __builtin_bit_cast(u32, r); }
DI u16 bf1(float a) { return (u16)(pk2(a, 0.f) & 0xffffu); }
DI int crow(int i, int hi) { return (i & 3) + 8 * (i >> 2) + 4 * hi; }
DI float wave_sum(float v) {
#pragma unroll
  for (int o = 32; o > 0; o >>= 1) v += __shfl_xor(v, o);
  return v;
}
DI double shfl_up_d(double x, int o) { int lo = __double2loint(x), hi = __double2hiint(x); lo = __shfl_up(lo, o); hi = __shfl_up(hi, o); return __hiloint2double(hi, lo); }
DI int otid() { int t = threadIdx.x; asm volatile("" : "+v"(t)); return t; }
DI float ex2(float x) { return __builtin_amdgcn_exp2f(x); }
DI float lg2(float x) { return __builtin_amdgcn_logf(x); }
DI float silu_f(float v) { return v * __builtin_amdgcn_rcpf(1.f + __expf(-v)); }
DI float halves_sum(float x) { auto rr = __builtin_amdgcn_permlane32_swap(__float_as_uint(x), __float_as_uint(x), false, false); return __uint_as_float(rr[0]) + __uint_as_float(rr[1]); }
DI float halves_max(float x) { auto rr = __builtin_amdgcn_permlane32_swap(__float_as_uint(x), __float_as_uint(x), false, false); return fmaxf(__uint_as_float(rr[0]), __uint_as_float(rr[1])); }
DI void rope_cs(int pos, int fidx, float& c, float& s) {
  const float inv = ex2(-(float)fidx * (13.287712379549449f / 16.f));
  float rev = ((float)pos * inv) * 0.15915494309189535f;
  rev = rev - floorf(rev);
  s = __builtin_amdgcn_sinf(rev); c = __builtin_amdgcn_cosf(rev);
}

struct Bufs {
  u32* ctr; float* siluc; float* mod; u16* win; u16* wq; u16* wkv; u16* wout; u16* H; u16* GATE; u16* QM; u16* Y; float* TMP32;
  u16* CQN; u16* QF; u16* QS; u16* KF_P; u16* KS_P; u16* VFT_P; u16* VST_P; u16* KN_P; u16* KPE_P; u16* VM_P; u16* CKVN;
  u16* KF_S; u16* KS_S; u16* VFT_S; u16* VST_S; u16* KN_S; u16* KPE_S; u16* VM_S; u16* CKVC; float* LOGF; float* FP; float* FS;
};
DI Bufs make_bufs(unsigned char* ws) {
  Bufs B;
  B.ctr = (u32*)(ws + WS_CTR); B.siluc = (float*)(ws + WS_SILUC); B.mod = (float*)(ws + WS_MOD); B.win = (u16*)(ws + WS_WIN);
  B.wq = (u16*)(ws + WS_WQ); B.wkv = (u16*)(ws + WS_WKV); B.wout = (u16*)(ws + WS_WOUT); B.H = (u16*)(ws + WS_H); B.GATE = (u16*)(ws + WS_GATE);
  B.QM = (u16*)(ws + WS_QM); B.Y = (u16*)(ws + WS_QM); B.TMP32 = (float*)(ws + WS_TMP32); B.CQN = (u16*)(ws + WS_CQN);
  B.QF = (u16*)(ws + WS_QF); B.QS = (u16*)(ws + WS_QS); B.KF_P = (u16*)(ws + WS_KF_P); B.KS_P = (u16*)(ws + WS_KS_P);
  B.VFT_P = (u16*)(ws + WS_VFT_P); B.VST_P = (u16*)(ws + WS_VST_P); B.KN_P = (u16*)(ws + WS_KN_P); B.KPE_P = (u16*)(ws + WS_KPE_P); B.VM_P = (u16*)(ws + WS_VM_P); B.CKVN = (u16*)(ws + WS_CKVN);
  B.KF_S = (u16*)(ws + WS_KF_S); B.KS_S = (u16*)(ws + WS_KS_S); B.VFT_S = (u16*)(ws + WS_VFT_S); B.VST_S = (u16*)(ws + WS_VST_S);
  B.KN_S = (u16*)(ws + WS_KN_S); B.KPE_S = (u16*)(ws + WS_KPE_S); B.VM_S = (u16*)(ws + WS_VM_S); B.CKVC = (u16*)(ws + WS_CKVC); B.LOGF = (float*)(ws + WS_LOGF); B.FP = (float*)(ws + WS_FP); B.FS = (float*)(ws + WS_FS);
  return B;
}


#define XB_TMO      128
#define XB_XCNT(j)  (256  + 64 * (j))
#define XB_XSUB(j)  (1280 + 64 * (j))
#define XB_XGEN(j)  (2304 + 64 * (j))
#define XB_TOP      3328
#define XB_TOPGEN   3392
#define XCD_BAR_WORDS 3456
#define XB_SPIN_CAP (1u << 22)
#define LAS __attribute__((address_space(3)))
DI unsigned xb_ld(unsigned* p) { return __hip_atomic_load(p, __ATOMIC_RELAXED, __HIP_MEMORY_SCOPE_AGENT); }
DI unsigned xb_add(unsigned* p, unsigned v) { return __hip_atomic_fetch_add(p, v, __ATOMIC_RELAXED, __HIP_MEMORY_SCOPE_AGENT); }
DI unsigned xb_xcc_id() { return (unsigned)__builtin_amdgcn_s_getreg((3 << 11) | 20) & 0xFu; }
#define XB_SPIN(cond, bar) do { unsigned _sp = 0; while (cond) { __builtin_amdgcn_s_sleep(1); \
    if ((++_sp & 255u) == 0u) { if (xb_ld(&(bar)[XB_TMO])) break; if (_sp > XB_SPIN_CAP) { atomicAdd(&(bar)[XB_TMO], 1u); break; } } } } while (0)
struct XcdBarrier { unsigned* bar; unsigned x; volatile LAS unsigned* st; };
DI XcdBarrier xcd_barrier_post(unsigned* bar, volatile LAS unsigned* st) {
  XcdBarrier b; b.bar = bar; b.x = xb_xcc_id(); b.st = st;
  if (threadIdx.x == 0) (void)xb_add(&bar[XB_XCNT(b.x)], 1u);
  return b;
}
DI void xcd_barrier_complete(unsigned* bar, unsigned x, unsigned& nloc, unsigned& nx) {
  const unsigned G = gridDim.x * gridDim.y * gridDim.z;
  unsigned sum, cnt, mine, sp = 0u;
  for (;;) {
    sum = 0u; cnt = 0u; mine = 0u;
#pragma unroll
    for (unsigned j = 0; j < 16; ++j) { const unsigned c = xb_ld(&bar[XB_XCNT(j)]); sum += c; cnt += (c > 0u) ? 1u : 0u; mine = (j == x) ? c : mine; }
    if (sum == G) break;
    __builtin_amdgcn_s_sleep(1);
    if ((++sp & 255u) == 0u) { if (xb_ld(&bar[XB_TMO])) break; if (sp > XB_SPIN_CAP) { atomicAdd(&bar[XB_TMO], 1u); break; } }
  }
  nloc = mine > 0u ? mine : 1u; nx = cnt > 0u ? cnt : 1u;
}
DI void xcd_barrier(const XcdBarrier& b) {
  asm volatile("s_waitcnt vmcnt(0)" ::: "memory");
  __syncthreads();
  if (threadIdx.x == 0) {
    unsigned* bar = b.bar;
    __builtin_amdgcn_s_waitcnt(0);
    unsigned nloc = b.st[0], nx = b.st[1];
    if (nloc == 0u) { xcd_barrier_complete(bar, b.x, nloc, nx); b.st[0] = nloc; b.st[1] = nx; }
    const unsigned old = xb_add(&bar[XB_XSUB(b.x)], 1u);
    const unsigned gen = old / nloc;
    if (old + 1u == (gen + 1u) * nloc) {
      __builtin_amdgcn_fence(__ATOMIC_RELEASE, "agent");
      asm volatile("s_waitcnt vmcnt(0)" ::: "memory");
      const unsigned og = xb_add(&bar[XB_TOP], 1u);
      const unsigned tg = og / nx;
      if (og + 1u == (tg + 1u) * nx) xb_add(&bar[XB_TOPGEN], 1u);
      else XB_SPIN(xb_ld(&bar[XB_TOPGEN]) == tg, bar);
      __builtin_amdgcn_fence(__ATOMIC_ACQUIRE, "agent");
      xb_add(&bar[XB_XGEN(b.x)], 1u);
      asm volatile("s_waitcnt vmcnt(0)" ::: "memory");
    } else {
      XB_SPIN(xb_ld(&bar[XB_XGEN(b.x)]) == gen, bar);
      __builtin_amdgcn_fence(__ATOMIC_ACQUIRE, "agent");
      asm volatile("s_waitcnt vmcnt(0)" ::: "memory");
    }
  }
  __syncthreads();
}

DI int in_colmap(int n) { return n < 768 ? n : n < 2432 ? n + 4 : n < 2944 ? n + 36 : n < 2976 ? n - 508 : n < 2980 ? n - 2208 : -1; }

DI void phase_prep(const Params& P, const Bufs& B) {
  const size_t gtid = (size_t)blockIdx.x * 256 + otid(), gsz = (size_t)gridDim.x * 256;
  for (size_t i = gtid; i < 16 * 1024; i += gsz) {
    const float c = i < 8192 ? P.c_prompt[i] : P.c_sample[i - 8192];
    B.siluc[i] = c / (1.f + __expf(-c));
  }
  for (size_t i = gtid; i < (size_t)2 * 128 * 3072; i += gsz) {
    const int n = (int)(i % 3072); const int kc = (int)((i / 3072) % 128); const int l = (int)(i / (3072 * 128));
    const int col = in_colmap(n);
    float v[8];
#pragma unroll
    for (int j = 0; j < 8; ++j) v[j] = col >= 0 ? P.w_in[((size_t)l * 1024 + kc * 8 + j) * 2980 + col] : 0.f;
    uint4 o = {pk2(v[0], v[1]), pk2(v[2], v[3]), pk2(v[4], v[5]), pk2(v[6], v[7])};
    *(uint4*)(B.win + ((size_t)l * 3072 + n) * 1024 + kc * 8) = o;
  }
  for (size_t i = gtid; i < (size_t)2 * 128 * 1024; i += gsz) {
    const int n = (int)(i & 1023); const int kc = (int)((i >> 10) & 127); const int l = (int)(i >> 17);
    float v[8];
#pragma unroll
    for (int j = 0; j < 8; ++j) v[j] = P.w_out[((size_t)l * 1024 + kc * 8 + j) * 1024 + n];
    uint4 o = {pk2(v[0], v[1]), pk2(v[2], v[3]), pk2(v[4], v[5]), pk2(v[6], v[7])};
    *(uint4*)(B.wout + ((size_t)l * 1024 + n) * 1024 + kc * 8) = o;
  }
  for (size_t i = gtid; i < (size_t)2 * 32 * 768; i += gsz) {
    const int n = (int)(i % 768); const int kc = (int)((i / 768) & 31); const int l = (int)(i / (768 * 32));
    float v[8];
#pragma unroll
    for (int j = 0; j < 8; ++j) v[j] = P.w_uq[((size_t)l * 256 + kc * 8 + j) * 768 + n];
    uint4 o = {pk2(v[0], v[1]), pk2(v[2], v[3]), pk2(v[4], v[5]), pk2(v[6], v[7])};
    *(uint4*)(B.wq + ((size_t)l * 768 + n) * 256 + kc * 8) = o;
  }
  for (size_t i = gtid; i < (size_t)2 * 16 * 1024; i += gsz) {
    const int n = (int)(i & 1023); const int kc = (int)((i >> 10) & 15); const int l = (int)(i >> 14);
    const float* srcw = (n < 512 ? P.w_uk : P.w_uv) + (size_t)l * 128 * 512 + (n & 511);
    float v[8];
#pragma unroll
    for (int j = 0; j < 8; ++j) v[j] = srcw[(size_t)(kc * 8 + j) * 512];
    uint4 o = {pk2(v[0], v[1]), pk2(v[2], v[3]), pk2(v[4], v[5]), pk2(v[6], v[7])};
    *(uint4*)(B.wkv + ((size_t)l * 1024 + n) * 128 + kc * 8) = o;
  }
}

DI void phase_mod(const Params& P, const Bufs& B, char* lds) {
  float* sc = (float*)lds;
  const int tid = otid();
  for (int u = blockIdx.x; u < 192; u += gridDim.x) {
    const int l = u / 96, j0 = (u % 96) * 32;
    __syncthreads();
    for (int i = tid; i < 16 * 1024 / 4; i += 256) ((float4*)sc)[i] = ((const float4*)B.siluc)[i];
    __syncthreads();
    const int jj = tid & 31, kq = tid >> 5;
    float acc[16];
#pragma unroll
    for (int i = 0; i < 16; ++i) acc[i] = 0.f;
    const float* wp = P.w_ada + ((size_t)l * 1024 + kq * 128) * 3072 + j0 + jj;
#pragma unroll 4
    for (int k = 0; k < 128; ++k) {
      const float wv = wp[(size_t)k * 3072];
#pragma unroll
      for (int i = 0; i < 16; ++i) acc[i] += sc[i * 1024 + kq * 128 + k] * wv;
    }
    __syncthreads();
    float* red = (float*)lds;
#pragma unroll
    for (int i = 0; i < 16; ++i) red[(kq * 16 + i) * 32 + jj] = acc[i];
    __syncthreads();
    for (int o = tid; o < 512; o += 256) {
      const int i = o >> 5, j = o & 31;
      float s = 0.f;
#pragma unroll
      for (int q = 0; q < 8; ++q) s += red[(q * 16 + i) * 32 + j];
      B.mod[((size_t)l * 16 + i) * 3072 + j0 + j] = s + P.b_ada[l * 3072 + j0 + j];
    }
  }
  __syncthreads();
}

DI void phase_D(const Params& P, const Bufs& B, int l) {
  const int tid_ = otid(); const int lane = tid_ & 63, w = tid_ >> 6;
  for (int row0 = (blockIdx.x * 4 + w) * 2; row0 < R; row0 += gridDim.x * 8) {
    float4 xv[2][4];
    int mi[2];
#pragma unroll
    for (int r = 0; r < 2; ++r) { const int row = row0 + r; mi[r] = row < NP ? (row >> 12) : 8 + ((row - NP) >> 4); }
    if (l == 0) {
#pragma unroll
      for (int r = 0; r < 2; ++r) {
        const int row = row0 + r;
        const float* xin = row < NP ? P.x_prompt + (size_t)row * 1024 : P.x_sample + (size_t)(row - NP) * 1024;
#pragma unroll
        for (int j = 0; j < 4; ++j) xv[r][j] = ((const float4*)xin)[j * 64 + lane];
      }
    } else {
      uint2 yb[2][4]; float4 xo[2][4];
#pragma unroll
      for (int r = 0; r < 2; ++r) {
        const int row = row0 + r;
        const float* xin = row < NP ? P.x_prompt + (size_t)row * 1024 : P.x_sample + (size_t)(row - NP) * 1024;
        const float* xp = (l == 1) ? xin : P.out + O_Y + (size_t)row * 1024;
        const u16* Yr = B.Y + (size_t)row * 1024;
#pragma unroll
        for (int j = 0; j < 4; ++j) { yb[r][j] = ((const uint2*)Yr)[j * 64 + lane]; xo[r][j] = ((const float4*)xp)[j * 64 + lane]; }
      }
      const float* gp = P.g_post + (size_t)(l - 1) * 1024;
#pragma unroll
      for (int r = 0; r < 2; ++r) {
        const int row = row0 + r;
        float4 yv[4]; float ss = 0.f;
#pragma unroll
        for (int j = 0; j < 4; ++j) {
          yv[j].x = __uint_as_float(yb[r][j].x << 16); yv[j].y = __uint_as_float(yb[r][j].x & 0xffff0000u);
          yv[j].z = __uint_as_float(yb[r][j].y << 16); yv[j].w = __uint_as_float(yb[r][j].y & 0xffff0000u);
          ss += yv[j].x * yv[j].x + yv[j].y * yv[j].y + yv[j].z * yv[j].z + yv[j].w * yv[j].w;
        }
        ss = wave_sum(ss);
        const float rs = rsqrtf(ss * (1.f / 1024.f) + EPSN);
        const float* gate = B.mod + ((size_t)(l - 1) * 16 + mi[r]) * 3072 + 2048;
        float* orow = P.out + O_Y + (size_t)row * 1024;
#pragma unroll
        for (int j = 0; j < 4; ++j) {
          const float4 g = ((const float4*)gate)[j * 64 + lane];
          const float4 q = ((const float4*)gp)[j * 64 + lane];
          xv[r][j].x = xo[r][j].x + g.x * (yv[j].x * rs * q.x); xv[r][j].y = xo[r][j].y + g.y * (yv[j].y * rs * q.y);
          xv[r][j].z = xo[r][j].z + g.z * (yv[j].z * rs * q.z); xv[r][j].w = xo[r][j].w + g.w * (yv[j].w * rs * q.w);
          ((float4*)orow)[j * 64 + lane] = xv[r][j];
        }
      }
    }
    if (l < 2) {
      const float* gp = P.g_pre + (size_t)l * 1024;
#pragma unroll
      for (int r = 0; r < 2; ++r) {
        const int row = row0 + r;
        float ss = 0.f;
#pragma unroll
        for (int j = 0; j < 4; ++j) ss += xv[r][j].x * xv[r][j].x + xv[r][j].y * xv[r][j].y + xv[r][j].z * xv[r][j].z + xv[r][j].w * xv[r][j].w;
        ss = wave_sum(ss);
        const float rs = rsqrtf(ss * (1.f / 1024.f) + EPSN);
        const float* md = B.mod + ((size_t)l * 16 + mi[r]) * 3072;
#pragma unroll
        for (int j = 0; j < 4; ++j) {
          const float4 sh = ((const float4*)md)[j * 64 + lane];
          const float4 scl = ((const float4*)(md + 1024))[j * 64 + lane];
          const float4 g = ((const float4*)gp)[j * 64 + lane];
          const float h0 = xv[r][j].x * rs * g.x * (1.f + scl.x) + sh.x, h1 = xv[r][j].y * rs * g.y * (1.f + scl.y) + sh.y;
          const float h2 = xv[r][j].z * rs * g.z * (1.f + scl.z) + sh.z, h3 = xv[r][j].w * rs * g.w * (1.f + scl.w) + sh.w;
          *(uint2*)(B.H + (size_t)row * 1024 + (j * 64 + lane) * 4) = make_uint2(pk2(h0, h1), pk2(h2, h3));
        }
      }
    }
  }
}

constexpr int GP = 72;
template <class Epi, bool SW>
DI void gemm_tile(const u16* __restrict__ A, int lda, const u16* __restrict__ Bt, int ldb, int K, int m0, int n0, char* lds, const Epi& epi) {
  const int tid = otid(), lane = tid & 63, w = tid >> 6, r32 = lane & 31, hi = lane >> 5;
  const int wm = w >> 1, wn = w & 1;
  u16* As0 = (u16*)lds; u16* Bs0 = As0 + 2 * 128 * GP;
  f32x16 acc00, acc01, acc10, acc11;
#pragma unroll
  for (int i = 0; i < 16; ++i) { acc00[i] = 0.f; acc01[i] = 0.f; acc10[i] = 0.f; acc11[i] = 0.f; }
  const int srow = tid >> 3, skc = tid & 7;
  const u16* Ag = A + (size_t)(m0 + srow) * lda + skc * 8;
  const u16* Bg = Bt + (size_t)(n0 + srow) * ldb + skc * 8;
  const size_t a32 = (size_t)32 * lda, b32 = (size_t)32 * ldb;
  uint4 pa0, pa1, pa2, pa3, pb0, pb1, pb2, pb3;
  uint4 qa0, qa1, qa2, qa3, qb0, qb1, qb2, qb3;
#define GLOAD(S, kt_) { const int ko_ = (kt_) * 64; \
    S##a0 = *(const uint4*)(Ag + ko_); S##a1 = *(const uint4*)(Ag + a32 + ko_); S##a2 = *(const uint4*)(Ag + 2 * a32 + ko_); S##a3 = *(const uint4*)(Ag + 3 * a32 + ko_); \
    S##b0 = *(const uint4*)(Bg + ko_); S##b1 = *(const uint4*)(Bg + b32 + ko_); S##b2 = *(const uint4*)(Bg + 2 * b32 + ko_); S##b3 = *(const uint4*)(Bg + 3 * b32 + ko_); }
#define GSTORE(S, st_) { u16* Aw = As0 + (st_) * 128 * GP + srow * GP + skc * 8; u16* Bw = Bs0 + (st_) * 128 * GP + srow * GP + skc * 8; \
    *(uint4*)(Aw) = S##a0; *(uint4*)(Aw + 32 * GP) = S##a1; *(uint4*)(Aw + 64 * GP) = S##a2; *(uint4*)(Aw + 96 * GP) = S##a3; \
    *(uint4*)(Bw) = S##b0; *(uint4*)(Bw + 32 * GP) = S##b1; *(uint4*)(Bw + 64 * GP) = S##b2; *(uint4*)(Bw + 96 * GP) = S##b3; }
#define GCOMPUTE(st_) { const u16* As = As0 + (st_) * 128 * GP; const u16* Bs = Bs0 + (st_) * 128 * GP; __builtin_amdgcn_s_setprio(3); \
    _Pragma("unroll") for (int ks = 0; ks < 4; ++ks) { \
      const bf16x8 a0 = *(const bf16x8*)(As + (wm * 64 + r32) * GP + ks * 16 + hi * 8); \
      const bf16x8 a1 = *(const bf16x8*)(As + (wm * 64 + 32 + r32) * GP + ks * 16 + hi * 8); \
      const bf16x8 b0 = *(const bf16x8*)(Bs + (wn * 64 + r32) * GP + ks * 16 + hi * 8); \
      const bf16x8 b1 = *(const bf16x8*)(Bs + (wn * 64 + 32 + r32) * GP + ks * 16 + hi * 8); \
      if (SW) { acc00 = MFMA(b0, a0, acc00); acc01 = MFMA(b1, a0, acc01); acc10 = MFMA(b0, a1, acc10); acc11 = MFMA(b1, a1, acc11); } \
      else { acc00 = MFMA(a0, b0, acc00); acc01 = MFMA(a0, b1, acc01); acc10 = MFMA(a1, b0, acc10); acc11 = MFMA(a1, b1, acc11); } } __builtin_amdgcn_s_setprio(0); }
  const int nk = K >> 6;
  GLOAD(p, 0)
  GLOAD(q, 1)
  GSTORE(p, 0)
  __syncthreads();
  for (int kt = 0; kt < nk; kt += 2) {
    if (kt + 2 < nk) GLOAD(p, kt + 2)
    __builtin_amdgcn_sched_barrier(0);
    GCOMPUTE(0)
    GSTORE(q, 1)
    __syncthreads();
    if (kt + 3 < nk) GLOAD(q, kt + 3)
    __builtin_amdgcn_sched_barrier(0);
    GCOMPUTE(1)
    if (kt + 2 < nk) GSTORE(p, 0)
    __syncthreads();
  }
#undef GLOAD
#undef GSTORE
#undef GCOMPUTE
  epi.template run<SW>(m0 + wm * 64, n0 + wn * 64, acc00, r32, hi);
  epi.template run<SW>(m0 + wm * 64, n0 + wn * 64 + 32, acc01, r32, hi);
  epi.template run<SW>(m0 + wm * 64 + 32, n0 + wn * 64, acc10, r32, hi);
  epi.template run<SW>(m0 + wm * 64 + 32, n0 + wn * 64 + 32, acc11, r32, hi);
}

struct EpiIn {
  const Params& P; const Bufs& B; int l;
  template <bool SW>
  DI void run(int rowbase, int colbase, const f32x16 v, int r32, int hi) const {
    const bool samp = rowbase >= NP;
    if (!SW) {
      const u32 rb = (u32)rowbase + 4u * hi;
      const int seg = colbase >> 8; const u32 c = (colbase & 255) + r32;
      const int grp = seg >> 2;
      const u32 ob = samp ? rb - NP : rb;
      float* o = P.out + (samp ? (grp ? O_SSV : O_SFV) + (size_t)l * 32768 : (grp ? O_PSV : O_PFV) + (size_t)l * 8388608) + ob * 256u + c;
      u16* Vb = (u16*)(P.ws + (samp ? (grp ? WS_VST_S : WS_VFT_S) : (grp ? WS_VST_P : WS_VFT_P)));
#pragma unroll
      for (int g = 0; g < 4; ++g) {
#pragma unroll
        for (int j = 0; j < 4; ++j) o[(8 * g + j) * 256] = v[4 * g + j];
        const u32 row0 = rb + 8 * g, orow0 = ob + 8 * g;
        const u32 bb = samp ? (orow0 >> 4) : (row0 >> 12);
        const u32 t0 = samp ? 2048u + (orow0 & 15u) : (row0 & 4095u);
        const u32 T = samp ? T_S : 4096;
        uint2 pkv = {pk2(v[4 * g], v[4 * g + 1]), pk2(v[4 * g + 2], v[4 * g + 3])};
        *(uint2*)(Vb + ((bb * 256u + c) * T + t0)) = pkv;
      }
      return;
    }
    const u32 tok = (u32)rowbase + r32;
    const u32 otok = samp ? tok - NP : tok;
    if (colbase < 2048) {
      const int seg = colbase >> 8; const u32 c0 = (colbase & 255) + 4u * hi;
      const int kind = seg & 3, grp = seg >> 2;
      if (kind == 0) {
        u16* Q = (u16*)(P.ws + (grp ? WS_QS : WS_QF)) + tok * 256u + c0;
#pragma unroll
        for (int g = 0; g < 4; ++g) *(uint2*)(Q + 8 * g) = make_uint2(pk2(v[4 * g] * QSC, v[4 * g + 1] * QSC), pk2(v[4 * g + 2] * QSC, v[4 * g + 3] * QSC));
      } else if (kind == 1) {
        float* o = P.out + (samp ? (grp ? O_SSK : O_SFK) + (size_t)l * 32768 : (grp ? O_PSK : O_PFK) + (size_t)l * 8388608) + otok * 256u + c0;
        const u32 krow_ = samp ? ((otok >> 4) * T_S + 2048u + (otok & 15u)) : tok;
        u16* Kb = (u16*)(P.ws + (samp ? (grp ? WS_KS_S : WS_KF_S) : (grp ? WS_KS_P : WS_KF_P))) + krow_ * 256u + c0;
#pragma unroll
        for (int g = 0; g < 4; ++g) {
          *(float4*)(o + 8 * g) = make_float4(v[4 * g], v[4 * g + 1], v[4 * g + 2], v[4 * g + 3]);
          *(uint2*)(Kb + 8 * g) = make_uint2(pk2(v[4 * g], v[4 * g + 1]), pk2(v[4 * g + 2], v[4 * g + 3]));
        }
        if (grp == 0 && !samp) {
          float ss = 0.f;
#pragma unroll
          for (int i = 0; i < 16; ++i) ss += v[i] * v[i];
#pragma unroll
          for (int o2 = 16; o2 > 0; o2 >>= 1) ss = fmaxf(ss, __shfl_xor(ss, o2));
          if (r32 == 0) {
            const int hh_ = (colbase & 255) >> 6, part = ((colbase >> 5) & 1) * 2 + hi, bb_ = rowbase >> 12;
            atomicMax((u32*)(P.ws + WS_KMAX) + ((l * 8 + bb_) * 4 + hh_) * 4 + part, __float_as_uint(ss));
          }
        }
      } else {
        u16* G = B.GATE + tok * 1024u + grp * 256 + c0;
#pragma unroll
        for (int g = 0; g < 4; ++g) *(uint2*)(G + 8 * g) = make_uint2(pk2(silu_f(v[4 * g]), silu_f(v[4 * g + 1])), pk2(silu_f(v[4 * g + 2]), silu_f(v[4 * g + 3])));
      }
    } else if (colbase < 2432 || colbase == 2944) {
      float* Tp = B.TMP32 + tok * 416u + (colbase == 2944 ? 384 : colbase - 2048) + 4 * hi;
#pragma unroll
      for (int g = 0; g < 4; ++g) *(float4*)(Tp + 8 * g) = make_float4(v[4 * g], v[4 * g + 1], v[4 * g + 2], v[4 * g + 3]);
    } else if (colbase < 2944) {
      u16* G = B.GATE + tok * 1024u + 512 + (colbase - 2432) + 4 * hi;
#pragma unroll
      for (int g = 0; g < 4; ++g) *(uint2*)(G + 8 * g) = make_uint2(pk2(silu_f(v[4 * g]), silu_f(v[4 * g + 1])), pk2(silu_f(v[4 * g + 2]), silu_f(v[4 * g + 3])));
    } else if (colbase == 2976) {
      if (hi == 0) {
        float lf[4];
#pragma unroll
        for (int j = 0; j < 4; ++j) { const float x = v[j] + P.b_f[l * 4 + j]; lf[j] = fminf(x, 0.f) - __logf(1.f + __expf(-fabsf(x))); }
        const float4 o4 = make_float4(lf[0], lf[1], lf[2], lf[3]);
        *(float4*)(P.out + (samp ? O_SLF + (size_t)l * 512 : O_PLF + (size_t)l * 131072) + otok * 4u) = o4;
        *(float4*)(B.LOGF + tok * 4u) = o4;
      }
    }
  }
};

struct EpiQ {
  const Bufs& B;
  template <bool SW>
  DI void run(int rowbase, int colbase, const f32x16 v, int r32, int hi) const {
    const int within = colbase % 96;
    const u32 tok = (u32)rowbase + r32;
    u16* Q = B.QM + tok * 768u + colbase + 4 * hi;
    if (within < 64) {
#pragma unroll
      for (int g = 0; g < 4; ++g) *(uint2*)(Q + 8 * g) = make_uint2(pk2(v[4 * g] * MSC, v[4 * g + 1] * MSC), pk2(v[4 * g + 2] * MSC, v[4 * g + 3] * MSC));
    } else {
      const int pos = tok < NP ? (int)(tok & 4095u) : 2048 + (int)((tok - NP) & 15u);
#pragma unroll
      for (int g = 0; g < 2; ++g) {
        float o1[4], o2[4];
#pragma unroll
        for (int j = 0; j < 4; ++j) {
          float c, s; rope_cs(pos, 8 * g + 4 * hi + j, c, s);
          const float x1 = v[4 * g + j], x2 = v[4 * (g + 2) + j];
          o1[j] = (x1 * c - x2 * s) * MSC; o2[j] = (x2 * c + x1 * s) * MSC;
        }
        *(uint2*)(Q + 8 * g) = make_uint2(pk2(o1[0], o1[1]), pk2(o1[2], o1[3]));
        *(uint2*)(Q + 8 * (g + 2)) = make_uint2(pk2(o2[0], o2[1]), pk2(o2[2], o2[3]));
      }
    }
  }
};

struct EpiKV {
  const Params& P; int cache;
  template <bool SW>
  DI void run(int rowbase, int colbase, const f32x16 v, int r32, int hi) const {
    if (SW) {
      const u32 tok = (u32)rowbase + r32;
      u32 krow_; size_t base;
      if (cache) { krow_ = (tok >> 11) * T_S + (tok & 2047u); base = WS_KN_S; }
      else if (tok >= NP) { const u32 ot = tok - NP; krow_ = (ot >> 4) * T_S + 2048u + (ot & 15u); base = WS_KN_S; }
      else { krow_ = tok; base = WS_KN_P; }
      u16* Kp = (u16*)(P.ws + base) + krow_ * 512u + colbase + 4 * hi;
#pragma unroll
      for (int g = 0; g < 4; ++g) *(uint2*)(Kp + 8 * g) = make_uint2(pk2(v[4 * g], v[4 * g + 1]), pk2(v[4 * g + 2], v[4 * g + 3]));
    } else {
      const u32 c = (u32)(colbase - 512) + r32;
      const u32 rb = (u32)rowbase + 4u * hi;
#pragma unroll
      for (int g = 0; g < 4; ++g) {
        const u32 row0 = rb + 8 * g;
        u32 bb, t0, T; size_t base;
        if (cache) { bb = row0 >> 11; t0 = row0 & 2047u; T = T_S; base = WS_VM_S; }
        else if (row0 >= NP) { const u32 ot = row0 - NP; bb = ot >> 4; t0 = 2048u + (ot & 15u); T = T_S; base = WS_VM_S; }
        else { bb = row0 >> 12; t0 = row0 & 4095u; T = 4096; base = WS_VM_P; }
        *(uint2*)((u16*)(P.ws + base) + ((bb * 512u + c) * T + t0)) = make_uint2(pk2(v[4 * g], v[4 * g + 1]), pk2(v[4 * g + 2], v[4 * g + 3]));
      }
    }
  }
};

struct EpiY {
  const Bufs& B;
  template <bool SW>
  DI void run(int rowbase, int colbase, const f32x16 v, int r32, int hi) const {
    u16* Yp = B.Y + ((u32)rowbase + r32) * 1024u + colbase + 4 * hi;
#pragma unroll
    for (int g = 0; g < 4; ++g) *(uint2*)(Yp + 8 * g) = make_uint2(pk2(v[4 * g], v[4 * g + 1]), pk2(v[4 * g + 2], v[4 * g + 3]));
  }
};

template <class Epi>
DI void phase_gemm(const u16* A, int lda, const u16* Bt, int ldb, int K, int ntn, char* lds, const Epi& epi, bool vsplit) {
  const int x = blockIdx.x & 7, j = blockIdx.x >> 3, nb = gridDim.x >> 3;
  if (ntn == 24) {
    const int nmt = (x >> 2) ? 129 : 128;
    for (int q = j; q < nmt * 6; q += nb) {
      const int ml = q / 6, nl = q - ml * 6;
      const int mt = (x >> 2) * 128 + ml, nt = (x & 3) * 6 + nl;
      if (vsplit && ((nt & 6) == 4) && nt < 16) gemm_tile<Epi, false>(A, lda, Bt, ldb, K, mt * 128, nt * 128, lds, epi);
      else gemm_tile<Epi, true>(A, lda, Bt, ldb, K, mt * 128, nt * 128, lds, epi);
    }
  } else {
    const int nmt = (x == 0) ? 33 : 32;
    for (int q = j; q < nmt * ntn; q += nb) {
      const int ml = q / ntn, nl = q - ml * ntn;
      const int mt = (ml < 32) ? x * 32 + ml : 256;
      gemm_tile<Epi, true>(A, lda, Bt, ldb, K, mt * 128, nl * 128, lds, epi);
    }
  }
}

DI void phase_A2b(const Params& P, const Bufs& B, int l, char* lds) {
  constexpr int NQ = (R / 128) * 6, NKV = (R / 128) * 8, NKC = 128 * 8;
  const EpiQ eq{B}; const EpiKV ekv{P, 0}; const EpiKV ekc{P, 1};
  const u16* wq = B.wq + (size_t)l * 768 * 256; const u16* wkv = B.wkv + (size_t)l * 1024 * 128;
  for (int t = blockIdx.x; t < NQ + NKV + NKC; t += gridDim.x) {
    if (t < NQ) { const int mt = t / 6, nt = t - mt * 6; gemm_tile<EpiQ, true>(B.CQN, 256, wq, 256, 256, mt * 128, nt * 128, lds, eq); }
    else if (t < NQ + NKV) {
      const int u = t - NQ; const int mt = u >> 3, nt = u & 7;
      if (nt < 4) gemm_tile<EpiKV, true>(B.CKVN, 128, wkv, 128, 128, mt * 128, nt * 128, lds, ekv);
      else gemm_tile<EpiKV, false>(B.CKVN, 128, wkv, 128, 128, mt * 128, nt * 128, lds, ekv);
    } else {
      const int u = t - NQ - NKV; const int mt = u >> 3, nt = u & 7;
      if (nt < 4) gemm_tile<EpiKV, true>(B.CKVC, 128, wkv, 128, 128, mt * 128, nt * 128, lds, ekc);
      else gemm_tile<EpiKV, false>(B.CKVC, 128, wkv, 128, 128, mt * 128, nt * 128, lds, ekc);
    }
  }
}

DI void phase_A2a(const Params& P, const Bufs& B, int l, char* lds) {
  const int tid = otid(), lane = tid & 63, w = tid >> 6;
  if (blockIdx.x < 16) {
    const int itb = blockIdx.x; const bool sp = itb >= 8; const int b = itb & 7;
    const int per = sp ? 9 : 16, total = sp ? 2064 : 4096, TT = sp ? T_S : 4096;
    const float4* c4 = (const float4*)(P.cache_fox_logf + ((size_t)l * 8 + b) * 2048 * 4);
    const float4* n4 = (const float4*)(B.LOGF + (sp ? ((size_t)NP + b * 16) * 4 : (size_t)b * 4096 * 4));
    const float4 zz = {0.f, 0.f, 0.f, 0.f};
    float4 v0 = zz, v1 = zz, v2 = zz, v3 = zz, v4 = zz, v5 = zz, v6 = zz, v7 = zz, v8 = zz, v9 = zz, v10 = zz, v11 = zz, v12 = zz, v13 = zz, v14 = zz, v15 = zz;
    double s0 = 0, s1 = 0, s2 = 0, s3 = 0;
#define FLD(i) if (i < per) { const int t = tid * per + i; if (t < total) v##i = sp ? (t < 2048 ? c4[t] : n4[t - 2048]) : n4[t]; s0 += v##i.x; s1 += v##i.y; s2 += v##i.z; s3 += v##i.w; }
    FLD(0) FLD(1) FLD(2) FLD(3) FLD(4) FLD(5) FLD(6) FLD(7) FLD(8) FLD(9) FLD(10) FLD(11) FLD(12) FLD(13) FLD(14) FLD(15)
#undef FLD
    double e0 = s0, e1 = s1, e2 = s2, e3 = s3;
#pragma unroll
    for (int o = 1; o < 64; o <<= 1) {
      const double t0 = shfl_up_d(e0, o), t1 = shfl_up_d(e1, o), t2 = shfl_up_d(e2, o), t3 = shfl_up_d(e3, o);
      if (lane >= o) { e0 += t0; e1 += t1; e2 += t2; e3 += t3; }
    }
    double* wt = (double*)lds;
    __syncthreads();
    if (lane == 63) { wt[w * 4 + 0] = e0; wt[w * 4 + 1] = e1; wt[w * 4 + 2] = e2; wt[w * 4 + 3] = e3; }
    __syncthreads();
    double r0 = e0 - s0, r1 = e1 - s1, r2 = e2 - s2, r3 = e3 - s3;
    for (int q = 0; q < w; ++q) { r0 += wt[q * 4 + 0]; r1 += wt[q * 4 + 1]; r2 += wt[q * 4 + 2]; r3 += wt[q * 4 + 3]; }
    float* d0 = (float*)(P.ws + (sp ? WS_FS : WS_FP)) + (size_t)b * 4 * TT;
#define FST(i) if (i < per) { const int t = tid * per + i; r0 += v##i.x; r1 += v##i.y; r2 += v##i.z; r3 += v##i.w; \
      if (t < TT) { d0[t] = (float)(r0 * (double)LOG2E); d0[TT + t] = (float)(r1 * (double)LOG2E); d0[2 * TT + t] = (float)(r2 * (double)LOG2E); d0[3 * TT + t] = (float)(r3 * (double)LOG2E); } }
    FST(0) FST(1) FST(2) FST(3) FST(4) FST(5) FST(6) FST(7) FST(8) FST(9) FST(10) FST(11) FST(12) FST(13) FST(14) FST(15)
#undef FST
    __syncthreads();
  }
  for (int g = blockIdx.x * 4 + w; g < R / 4; g += gridDim.x * 4) {
    const int row0 = g * 4;
    const bool samp = row0 >= NP;
    const int orow0 = samp ? row0 - NP : row0;
    const int bb = samp ? (orow0 >> 4) : (row0 >> 12);
    const int t0 = samp ? 2048 + (orow0 & 15) : (row0 & 4095);
    const int T = samp ? T_S : 4096;
    const size_t km0 = samp ? (size_t)bb * T_S + t0 : (size_t)row0;
    u16* KPE = (u16*)(P.ws + (samp ? WS_KPE_S : WS_KPE_P));
    const float4 gq = ((const float4*)(P.g_q_a + l * 256))[lane];
#pragma unroll
    for (int j = 0; j < 4; ++j) {
      const float4 v = *(const float4*)(B.TMP32 + (size_t)(row0 + j) * 416 + lane * 4);
      const float ss = wave_sum(v.x * v.x + v.y * v.y + v.z * v.z + v.w * v.w);
      const float rs = rsqrtf(ss * (1.f / 256.f) + EPSN);
      uint2 o = {pk2(v.x * rs * gq.x, v.y * rs * gq.y), pk2(v.z * rs * gq.z, v.w * rs * gq.w)};
      *(uint2*)(B.CQN + (size_t)(row0 + j) * 256 + lane * 4) = o;
    }
    const float2 gk = ((const float2*)(P.g_kv_a + l * 128))[lane];
    float* ockv = P.out + (samp ? O_SCKV + (size_t)l * 16384 : O_PCKV + (size_t)l * 4194304);
    float n0[4], n1[4];
#pragma unroll
    for (int j = 0; j < 4; ++j) {
      const float2 v = *(const float2*)(B.TMP32 + (size_t)(row0 + j) * 416 + 256 + lane * 2);
      const float ss = wave_sum(v.x * v.x + v.y * v.y);
      const float rs = rsqrtf(ss * (1.f / 128.f) + EPSN);
      n0[j] = v.x * rs * gk.x; n1[j] = v.y * rs * gk.y;
      float2 o = {n0[j], n1[j]};
      *(float2*)(ockv + (size_t)(orow0 + j) * 128 + lane * 2) = o;
      *(u32*)(B.CKVN + (size_t)(row0 + j) * 128 + lane * 2) = pk2(n0[j], n1[j]);
    }
    {
      const int j = lane >> 4, i = lane & 15;
      const float x1 = B.TMP32[(size_t)(row0 + j) * 416 + 384 + i], x2 = B.TMP32[(size_t)(row0 + j) * 416 + 400 + i];
      float c, s; rope_cs(t0 + j, i, c, s);
      const float o1 = x1 * c - x2 * s, o2 = x2 * c + x1 * s;
      float* okpe = P.out + (samp ? O_SKPE + (size_t)l * 4096 : O_PKPE + (size_t)l * 1048576);
      okpe[(size_t)(orow0 + j) * 32 + i] = o1; okpe[(size_t)(orow0 + j) * 32 + 16 + i] = o2;
      KPE[(km0 + j) * 32 + i] = bf1(o1); KPE[(km0 + j) * 32 + 16 + i] = bf1(o2);
    }
  }
  const size_t gtid = (size_t)blockIdx.x * 256 + tid, gsz = (size_t)gridDim.x * 256;
  for (size_t i = gtid; i < (size_t)2 * 8 * 2048 * 32; i += gsz) {
    const int which = (int)(i >> 19); const size_t r = i & 524287; const int cc = (int)(r & 31); const int bt = (int)(r >> 5);
    const int b = bt >> 11, t = bt & 2047;
    const float* src = (which ? P.cache_sb_k : P.cache_fox_k) + (((size_t)l * 8 + b) * 2048 + t) * 256 + cc * 8;
    const float4 v0 = ((const float4*)src)[0], v1 = ((const float4*)src)[1];
    uint4 o = {pk2(v0.x, v0.y), pk2(v0.z, v0.w), pk2(v1.x, v1.y), pk2(v1.z, v1.w)};
    *(uint4*)((u16*)(P.ws + (which ? WS_KS_S : WS_KF_S)) + ((size_t)b * T_S + t) * 256 + cc * 8) = o;
  }
  for (size_t i = gtid; i < (size_t)8 * 2048 * 20; i += gsz) {
    const int cc = (int)(i % 20); const int bt = (int)(i / 20); const int b = bt >> 11, t = bt & 2047;
    const float* srcp = cc < 16 ? P.cache_ckv + (((size_t)l * 8 + b) * 2048 + t) * 128 + cc * 8 : P.cache_kpe + (((size_t)l * 8 + b) * 2048 + t) * 32 + (cc - 16) * 8;
    const float4 v0 = ((const float4*)srcp)[0], v1 = ((const float4*)srcp)[1];
    uint4 o = {pk2(v0.x, v0.y), pk2(v0.z, v0.w), pk2(v1.x, v1.y), pk2(v1.z, v1.w)};
    if (cc < 16) *(uint4*)(B.CKVC + (size_t)bt * 128 + cc * 8) = o;
    else *(uint4*)(B.KPE_S + ((size_t)b * T_S + t) * 32 + (cc - 16) * 8) = o;
  }
  for (size_t i = gtid; i < (size_t)2 * 8 * 256 * 256; i += gsz) {
    const int which = (int)(i >> 19); const size_t r = i & 524287; const int hd = (int)(r & 255); const int t8 = (int)((r >> 8) & 255); const int b = (int)(r >> 16);
    const float* src = (which ? P.cache_sb_v : P.cache_fox_v) + (((size_t)l * 8 + b) * 2048 + t8 * 8) * 256 + hd;
    float v[8];
#pragma unroll
    for (int j = 0; j < 8; ++j) v[j] = src[(size_t)j * 256];
    uint4 o = {pk2(v[0], v[1]), pk2(v[2], v[3]), pk2(v[4], v[5]), pk2(v[6], v[7])};
    *(uint4*)((u16*)(P.ws + (which ? WS_VST_S : WS_VFT_S)) + ((size_t)b * 256 + hd) * T_S + t8 * 8) = o;
  }
  const uint4 z4 = {0u, 0u, 0u, 0u};
  for (size_t i = gtid; i < (size_t)8 * 48 * 32; i += gsz) {
    const int cc = (int)(i & 31); const int r = (int)((i >> 5) % 48); const int b = (int)(i / (48 * 32));
    *(uint4*)(B.KF_S + ((size_t)b * T_S + 2064 + r) * 256 + cc * 8) = z4;
    *(uint4*)(B.KS_S + ((size_t)b * T_S + 2064 + r) * 256 + cc * 8) = z4;
  }
  for (size_t i = gtid; i < (size_t)8 * 48 * 68; i += gsz) {
    const int cc = (int)(i % 68); const int r = (int)((i / 68) % 48); const int b = (int)(i / (48 * 68));
    if (cc < 64) *(uint4*)(B.KN_S + ((size_t)b * T_S + 2064 + r) * 512 + cc * 8) = z4;
    else *(uint4*)(B.KPE_S + ((size_t)b * T_S + 2064 + r) * 32 + (cc - 64) * 8) = z4;
  }
  for (size_t i = gtid; i < (size_t)8 * 512 * 6; i += gsz) {
    const int cc = (int)(i % 6); const int rr = (int)(i / 6);
    *(uint4*)(B.VM_S + (size_t)rr * T_S + 2064 + cc * 8) = z4;
    if (rr < 8 * 256) { *(uint4*)(B.VFT_S + (size_t)rr * T_S + 2064 + cc * 8) = z4; *(uint4*)(B.VST_S + (size_t)rr * T_S + 2064 + cc * 8) = z4; }
  }
}

typedef short v4i16_t __attribute__((ext_vector_type(4)));
DI uint2 lds_tr16(const u16* p) {
  const v4i16_t r = __builtin_amdgcn_ds_read_tr16_b64_v4i16((LAS v4i16_t*)(unsigned)(uintptr_t)p);
  return __builtin_bit_cast(uint2, r);
}
template <int TYPE>
DI void attn_item(const Params& P, const Bufs& B, int l, bool samp, int b, int hh, int qt, char* lds) {
  constexpr int DK = (TYPE == 2) ? 96 : 64, DV = 64;
  constexpr int KP = DK + 8, VP = 68;
  constexpr int NKC = 64 * DK / 8 / 256;
  constexpr int NVC = 2;
  constexpr int NDT = DV / 32;
  constexpr int NST = DK / 16;
  constexpr int STG = 64 * KP * 2 + 64 * VP * 2 + 256;
  const int tid = otid(), lane = tid & 63, w = tid >> 6, r32 = lane & 31, hi = lane >> 5;
  int head, qrow0, nvalid, qpos0, ntiles; bool active;
  if (!samp) { head = hh; qrow0 = b * 4096 + qt * 128 + w * 32; nvalid = 32; qpos0 = qt * 128 + w * 32; ntiles = 2 * qt + 2; active = true; }
  else {
    head = hh; active = (w == 0);
    qrow0 = NP + b * 16; nvalid = 16; qpos0 = 2048; ntiles = 33;
  }
  const int qi = r32 < nvalid ? r32 : nvalid - 1;
  const int qrow = qrow0 + qi, qpos = qpos0 + qi;
  const bool lane_valid = active && (r32 < nvalid);
  const int qlast = qpos0 + nvalid - 1;
  const int klim = samp ? 2064 : ((qpos0 >> 6) + 1) * 64;
  const u16* Kg; const u16* Kg2 = nullptr; const u16* Vg = nullptr; int kpitch, vpitch; const float* Fg = nullptr;
  {
    const int TT = samp ? T_S : 4096;
    vpitch = TT;
    if (TYPE == 2) {
      kpitch = 512;
      Kg = (const u16*)(P.ws + (samp ? WS_KN_S : WS_KN_P)) + (size_t)b * TT * 512 + head * 64;
      Kg2 = (const u16*)(P.ws + (samp ? WS_KPE_S : WS_KPE_P)) + (size_t)b * TT * 32;
      Vg = (const u16*)(P.ws + (samp ? WS_VM_S : WS_VM_P)) + ((size_t)(b * 8 + head) * 64) * TT;
    } else {
      kpitch = 256;
      Kg = (const u16*)(P.ws + (TYPE == 0 ? (samp ? WS_KF_S : WS_KF_P) : (samp ? WS_KS_S : WS_KS_P))) + (size_t)b * TT * 256 + head * 64;
      Vg = (const u16*)(P.ws + (TYPE == 0 ? (samp ? WS_VFT_S : WS_VFT_P) : (samp ? WS_VST_S : WS_VST_P))) + ((size_t)(b * 4 + head) * 64) * TT;
      Fg = (const float*)(P.ws + (samp ? WS_FS : WS_FP)) + (size_t)(b * 4 + head) * TT;
    }
  }
  const bf16x8 zb = {0, 0, 0, 0, 0, 0, 0, 0};
  bf16x8 qf0 = zb, qf1 = zb, qf2 = zb, qf3 = zb, qf4 = zb, qf5 = zb, qf6 = zb, qf7 = zb, qf8 = zb, qf9 = zb;
  {
    const u16* Qp = TYPE == 0 ? B.QF + (size_t)qrow * 256 + head * 64 : TYPE == 1 ? B.QS + (size_t)qrow * 256 + head * 64 : B.QM + (size_t)qrow * 768 + head * 96;
#define QLD(s) if (s < NST) qf##s = *(const bf16x8*)(Qp + s * 16 + hi * 8);
    QLD(0) QLD(1) QLD(2) QLD(3) QLD(4) QLD(5) QLD(6) QLD(7) QLD(8) QLD(9)
#undef QLD
  }
  float zmax = INFINITY;
  if (TYPE == 0 && !samp) {
    const float4 km = *(const float4*)((const float*)(P.ws + WS_KMAX) + ((l * 8 + b) * 4 + head) * 4);
    float qn = 0.f;
#define QSQ(s) _Pragma("unroll") for (int j = 0; j < 8; ++j) { const float x = __uint_as_float(((u32)(u16)qf##s[j]) << 16); qn += x * x; }
    QSQ(0) QSQ(1) QSQ(2) QSQ(3)
#undef QSQ
    qn = halves_sum(qn);
    zmax = sqrtf(qn * (km.x + km.y + km.z + km.w)) * 1.02f + 1e-3f;
  }
  f32x16 zf;
#pragma unroll
  for (int i = 0; i < 16; ++i) zf[i] = 0.f;
  f32x16 O0 = zf, O1 = zf, O2 = zf, O3 = zf;
  float m = (TYPE == 2) ? 0.f : -INFINITY, lsum = 0.f, carry = 1.f;
  f32x16 NM = zf;
  bool first = true;
  bool wdead = !active;
  volatile int* dflags = (volatile int*)(lds + 2 * STG);
  const uint4 z4 = {0u, 0u, 0u, 0u};
  uint4 rak0 = z4, rak1 = z4, rak2 = z4, rav0 = z4, rav1 = z4; float raf_ = 0.f;
  uint4 rbk0 = z4, rbk1 = z4, rbk2 = z4, rbv0 = z4, rbv1 = z4; float rbf_ = 0.f;
#define KLD(S, i) if (i < NKC) { const int c_ = tid + 256 * i; const int row_ = (DK == 64) ? (c_ >> 3) : (c_ / 12); const int cc_ = (DK == 64) ? (c_ & 7) : (c_ - row_ * 12); \
    S##k##i = (DK == 64 || cc_ < 8) ? *(const uint4*)(Kg + (size_t)(k0_ + row_) * kpitch + cc_ * 8) : *(const uint4*)(Kg2 + (size_t)(k0_ + row_) * 32 + (cc_ - 8) * 8); }
#define VLD(S, i) { const int c_ = tid + 256 * i; S##v##i = *(const uint4*)(Vg + (size_t)(c_ >> 3) * vpitch + k0_ + (c_ & 7) * 8); }
#define ATT_PREFETCH(S, it_) { const int k0_ = ((TYPE != 2) ? ntiles - 1 - (it_) : (it_)) * 64; KLD(S, 0) KLD(S, 1) KLD(S, 2) VLD(S, 0) VLD(S, 1) if (TYPE == 0 && tid < 64) S##f_ = Fg[k0_ + tid]; }
#define KST(S, i) if (i < NKC) { const int c_ = tid + 256 * i; const int row_ = (DK == 64) ? (c_ >> 3) : (c_ / 12); const int cc_ = (DK == 64) ? (c_ & 7) : (c_ - row_ * 12); *(uint4*)(KsW + row_ * KP + cc_ * 8) = S##k##i; }
#define VST(S, i) { const int c_ = tid + 256 * i; u16* vd_ = VsW + (c_ >> 3) * VP + (c_ & 7) * 8; *(uint2*)vd_ = make_uint2(S##v##i.x, S##v##i.y); *(uint2*)(vd_ + 4) = make_uint2(S##v##i.z, S##v##i.w); }
#define ATT_STORE(S, st_) { u16* KsW = (u16*)(lds + (st_) * STG); u16* VsW = KsW + 64 * KP; float* FsW = (float*)(VsW + 64 * VP); \
    KST(S, 0) KST(S, 1) KST(S, 2) VST(S, 0) VST(S, 1) if (TYPE == 0 && tid < 64) FsW[tid] = S##f_; }
  auto tile_compute = [&](const int cur, const int it) __attribute__((always_inline)) {
    const int k0 = ((TYPE != 2) ? ntiles - 1 - it : it) * 64;
    const u16* Ks = (const u16*)(lds + cur * STG); const u16* Vs = Ks + 64 * KP; const float* Fs = (const float*)(Vs + 64 * VP);
    if (TYPE == 0 && !wdead) {
      const float bound = zmax - Fs[63];
      wdead = !__any(bound - m > -130.f);
    }
    const bool doit = active && (TYPE == 0 ? (!wdead && k0 <= qlast) : TYPE == 1 ? (!wdead && k0 < qlast) : (k0 < klim));
    if (doit) {
      f32x16 S0 = (TYPE == 2) ? NM : zf, S1 = (TYPE == 2) ? NM : zf;
      bool allzero = false;
#define SBAR __builtin_amdgcn_sched_barrier(0);
#define RD(s) bf16x8 ka##s = zb, kb##s = zb, qq##s = qf##s; if (s < NST) { ka##s = *(const bf16x8*)(Ks + r32 * KP + s * 16 + hi * 8); kb##s = *(const bf16x8*)(Ks + (32 + r32) * KP + s * 16 + hi * 8); \
                }
#define MM(s) if (s < NST) { S0 = MFMA(ka##s, qq##s, S0); S1 = MFMA(kb##s, qq##s, S1); }
      RD(0) RD(1) SBAR RD(2) SBAR MM(0) SBAR RD(3) SBAR MM(1) SBAR RD(4) SBAR MM(2) SBAR RD(5) SBAR MM(3) SBAR RD(6) SBAR MM(4) SBAR
      RD(7) SBAR MM(5) SBAR RD(8) SBAR MM(6) SBAR RD(9) SBAR MM(7) SBAR MM(8) SBAR MM(9) SBAR
#undef RD
#undef MM
      if (TYPE == 1) {
        f32x16 R0, R1;
        const bool need_mask = (k0 + 63 >= qpos0);
#pragma unroll
        for (int i = 0; i < 16; ++i) {
          const float e0 = ex2(fminf(S0[i], 60.f)), e1 = ex2(fminf(S1[i], 60.f));
          const float r0 = __builtin_amdgcn_rcpf(1.f + e0), r1 = __builtin_amdgcn_rcpf(1.f + e1);
          R0[i] = r0; R1[i] = r1; S0[i] = e0 * r0; S1[i] = e1 * r1;
        }
        if (need_mask) {
#pragma unroll
          for (int i = 0; i < 16; ++i) {
            const int key = k0 + crow(i, hi);
            if (!(key < qpos)) { R0[i] = 1.f; S0[i] = 0.f; }
            if (!(key + 32 < qpos)) { R1[i] = 1.f; S1[i] = 0.f; }
          }
        }
        float Rr = carry;
#define SBG(RV, SV, g) { \
          const float gown = (RV[4 * g] * RV[4 * g + 1]) * (RV[4 * g + 2] * RV[4 * g + 3]); \
          const float goth = __shfl_xor(gown, 32); \
          float sfx = hi ? Rr : Rr * goth; \
          SV[4 * g + 3] *= sfx; sfx *= RV[4 * g + 3]; \
          SV[4 * g + 2] *= sfx; sfx *= RV[4 * g + 2]; \
          SV[4 * g + 1] *= sfx; sfx *= RV[4 * g + 1]; \
          SV[4 * g] *= sfx; \
          Rr *= gown * goth; }
        SBG(R1, S1, 3) SBG(R1, S1, 2) SBG(R1, S1, 1) SBG(R1, S1, 0)
        SBG(R0, S0, 3) SBG(R0, S0, 2) SBG(R0, S0, 1) SBG(R0, S0, 0)
#undef SBG
        carry = Rr;
        wdead = !__any(carry != 0.f);
      } else {
        if (TYPE == 0) {
#pragma unroll
          for (int g = 0; g < 4; ++g) {
            const float4 f0 = *(const float4*)(Fs + 8 * g + 4 * hi);
            const float4 f1 = *(const float4*)(Fs + 32 + 8 * g + 4 * hi);
            S0[4 * g] -= f0.x; S0[4 * g + 1] -= f0.y; S0[4 * g + 2] -= f0.z; S0[4 * g + 3] -= f0.w;
            S1[4 * g] -= f1.x; S1[4 * g + 1] -= f1.y; S1[4 * g + 2] -= f1.z; S1[4 * g + 3] -= f1.w;
          }
          if (k0 + 63 > qpos0) {
#pragma unroll
            for (int i = 0; i < 16; ++i) {
              const int key = k0 + crow(i, hi);
              if (key > qpos) S0[i] = -INFINITY;
              if (key + 32 > qpos) S1[i] = -INFINITY;
            }
          }
        } else {
          if (k0 + 64 > klim) {
#pragma unroll
            for (int i = 0; i < 16; ++i) {
              const int key = k0 + crow(i, hi);
              if (key >= klim) S0[i] = -INFINITY;
              if (key + 32 >= klim) S1[i] = -INFINITY;
            }
          }
        }
        float mx = S0[0];
#pragma unroll
        for (int i = 1; i < 16; ++i) mx = fmaxf(mx, S0[i]);
#pragma unroll
        for (int i = 0; i < 16; ++i) mx = fmaxf(mx, S1[i]);
        mx = halves_max(mx);
        if (TYPE == 2) {
          if (first || __any(mx > 8.f)) {
            const float dm = first ? mx : fmaxf(mx, 0.f);
            if (!first) {
              const float alpha = ex2(-dm);
              lsum *= alpha;
#pragma unroll
              for (int i = 0; i < 16; ++i) { O0[i] *= alpha; O1[i] *= alpha; }
            }
            m += dm;
#pragma unroll
            for (int i = 0; i < 16; ++i) { NM[i] = -m; S0[i] -= dm; S1[i] -= dm; }
            first = false;
          }
          float ps = 0.f;
#pragma unroll
          for (int i = 0; i < 16; ++i) { S0[i] = ex2(S0[i]); S1[i] = ex2(S1[i]); ps += S0[i] + S1[i]; }
          lsum += ps;
        } else {
        if (TYPE == 0) allzero = !__any(mx - m > -130.f);
        if (__any(mx > m + 8.f)) {
          const float mnew = fmaxf(m, mx);
          const float alpha = ex2(m - mnew);
          m = mnew;
          lsum *= alpha;
#pragma unroll
          for (int i = 0; i < 16; ++i) { O0[i] *= alpha; O1[i] *= alpha; if (NDT > 2) { O2[i] *= alpha; O3[i] *= alpha; } }
        }
        if (!allzero) {
          float ps = 0.f;
#pragma unroll
          for (int i = 0; i < 16; ++i) { S0[i] = ex2(S0[i] - m); S1[i] = ex2(S1[i] - m); ps += S0[i] + S1[i]; }
          lsum += ps;
        }
        }
      }
      if (!allzero) {
      const bf16x8 pf0 = __builtin_bit_cast(bf16x8, make_uint4(pk2(S0[0], S0[1]), pk2(S0[2], S0[3]), pk2(S0[4], S0[5]), pk2(S0[6], S0[7])));
      const bf16x8 pf1 = __builtin_bit_cast(bf16x8, make_uint4(pk2(S0[8], S0[9]), pk2(S0[10], S0[11]), pk2(S0[12], S0[13]), pk2(S0[14], S0[15])));
      const bf16x8 pf2 = __builtin_bit_cast(bf16x8, make_uint4(pk2(S1[0], S1[1]), pk2(S1[2], S1[3]), pk2(S1[4], S1[5]), pk2(S1[6], S1[7])));
      const bf16x8 pf3 = __builtin_bit_cast(bf16x8, make_uint4(pk2(S1[8], S1[9]), pk2(S1[10], S1[11]), pk2(S1[12], S1[13]), pk2(S1[14], S1[15])));
      const u16* vbase = Vs + r32 * VP + 4 * hi;
#define VRD(d, sp) bf16x8 vf##d##sp = zb; if (d < NDT) { const uint2 lo = *(const uint2*)(vbase + d * 32 * VP + 16 * sp); const uint2 h8 = *(const uint2*)(vbase + d * 32 * VP + 16 * sp + 8); \
        vf##d##sp = __builtin_bit_cast(bf16x8, make_uint4(lo.x, lo.y, h8.x, h8.y)); }
#define VMM(d, sp) if (d < NDT) { O##d = MFMA(vf##d##sp, pf##sp, O##d); }
      VRD(0, 0) VRD(1, 0) VRD(0, 1) SBAR VRD(1, 1) SBAR VMM(0, 0) SBAR VRD(0, 2) SBAR VMM(1, 0) SBAR VRD(1, 2) SBAR VMM(0, 1) SBAR VRD(0, 3) SBAR VMM(1, 1) SBAR VRD(1, 3) SBAR
      VMM(0, 2) SBAR VRD(2, 0) SBAR VMM(1, 2) SBAR VRD(3, 0) SBAR VMM(0, 3) SBAR VRD(2, 1) SBAR VMM(1, 3) SBAR VRD(3, 1) SBAR
      VMM(2, 0) SBAR VRD(2, 2) SBAR VMM(3, 0) SBAR VRD(3, 2) SBAR VMM(2, 1) SBAR VRD(2, 3) SBAR VMM(3, 1) SBAR VRD(3, 3) SBAR
      VMM(2, 2) SBAR VMM(3, 2) SBAR VMM(2, 3) SBAR VMM(3, 3) SBAR
#undef VRD
#undef VMM
#undef SBAR
      }
    }
  };
  ATT_PREFETCH(ra, 0)
  if (ntiles > 1) { ATT_PREFETCH(rb, 1) }
  ATT_STORE(ra, 0)
  __syncthreads();
  for (int it = 0; it < ntiles; it += 2) {
    if (it + 2 < ntiles) { ATT_PREFETCH(ra, it + 2) }
    __builtin_amdgcn_sched_barrier(0);
    tile_compute(0, it);
    if (it + 1 < ntiles) { ATT_STORE(rb, 1) }
    if (TYPE != 2 && lane == 0) dflags[w] = wdead ? 1 : 0;
    __syncthreads();
    if (TYPE != 2) { if (dflags[0] & dflags[1] & dflags[2] & dflags[3]) break; }
    if (it + 1 >= ntiles) break;
    if (it + 3 < ntiles) { ATT_PREFETCH(rb, it + 3) }
    __builtin_amdgcn_sched_barrier(0);
    tile_compute(1, it + 1);
    if (it + 2 < ntiles) { ATT_STORE(ra, 0) }
    if (TYPE != 2 && lane == 0) dflags[4 + w] = wdead ? 1 : 0;
    __syncthreads();
    if (TYPE != 2) { if (dflags[4] & dflags[5] & dflags[6] & dflags[7]) break; }
  }
#undef ATT_PREFETCH
#undef ATT_STORE
#undef KLD
#undef VLD
#undef KST
#undef VST
  if (active) {
    float inv = 1.f;
    if (TYPE != 1) { const float lt = halves_sum(lsum); inv = 1.f / lt; }
    const u32 orow = (u32)qrow * 1024u;
    {
      const int goff = (TYPE == 0 ? 0 : TYPE == 1 ? 256 : 512) + head * 64;
#define OEP(d) _Pragma("unroll") for (int g = 0; g < 4; ++g) { \
          const int dd = d * 32 + 8 * g + 4 * hi; \
          const uint2 gv = *(const uint2*)(B.GATE + orow + goff + dd); \
          const float g0 = __uint_as_float(gv.x << 16), g1 = __uint_as_float(gv.x & 0xffff0000u), g2 = __uint_as_float(gv.y << 16), g3 = __uint_as_float(gv.y & 0xffff0000u); \
          uint2 o = {pk2(O##d[4 * g] * inv * g0, O##d[4 * g + 1] * inv * g1), pk2(O##d[4 * g + 2] * inv * g2, O##d[4 * g + 3] * inv * g3)}; \
          if (lane_valid) *(uint2*)(B.H + orow + goff + dd) = o; }
      OEP(0) OEP(1)
#undef OEP
    }
  }
}

constexpr int N_Q_ITEMS = 16 + 512;
DI void phase_attn(const Params& P, const Bufs& B, int ci, int l, char* lds, int* s_item, int xcc, int only_type = -1) {
  for (int qx = 0; qx < 8; ++qx) {
    const int q = (xcc + qx) & 7;
    while (true) {
      __syncthreads();
      if (threadIdx.x == 0) *s_item = (int)atomicAdd(B.ctr + ci * 8 + q, 1u);
      __syncthreads();
      const int it = *s_item;
      if (it >= N_Q_ITEMS) break;
      bool samp; int type, hh, qt; const int b = q;
      if (it < 16) {
        samp = true; qt = 0;
        if (it < 8) { type = 2; hh = it; } else if (it < 12) { type = 0; hh = it - 8; } else { type = 1; hh = it - 12; }
      } else {
        const int j = it - 16;
        samp = false;
        qt = 31 - (j >> 4); const int k16 = j & 15;
        if (k16 & 1) { type = 2; hh = k16 >> 1; } else if (k16 & 2) { type = 0; hh = k16 >> 2; } else { type = 1; hh = k16 >> 2; }
      }
      if (only_type >= 0 && type != only_type) continue;
      if (type == 0) attn_item<0>(P, B, l, samp, b, hh, qt, lds);
      else if (type == 1) attn_item<1>(P, B, l, samp, b, hh, qt, lds);
      else attn_item<2>(P, B, l, samp, b, hh, qt, lds);
    }
  }
}

__global__ void __launch_bounds__(256, 2) fwd_megakernel(Params P) {
  cg::grid_group grid = cg::this_grid();
  __shared__ __attribute__((aligned(16))) char lds[73728];
  __shared__ int s_item;
  __shared__ uint4 xb_words;
  if (threadIdx.x == 0) xb_words = make_uint4(0u, 0u, 0u, 0u);
  __syncthreads();
  const XcdBarrier xb = xcd_barrier_post((unsigned*)(P.ws + WS_BAR), (volatile LAS unsigned*)&xb_words);
  if (P.ws == nullptr) grid.sync();
  const Bufs B = make_bufs(P.ws);
  phase_prep(P, B);
  xcd_barrier(xb);
  phase_mod(P, B, lds);
  xcd_barrier(xb);
  phase_D(P, B, 0);
  xcd_barrier(xb);
#pragma unroll 1
  for (int l = 0; l < 2; ++l) {
#pragma unroll 1
    for (int rep = 0; rep <= REP_GEMM; ++rep) { EpiIn e{P, B, l}; phase_gemm(B.H, 1024, B.win + (size_t)l * 3072 * 1024, 1024, 1024, 24, lds, e, true); }
    xcd_barrier(xb);
    phase_A2a(P, B, l, lds);
    xcd_barrier(xb);
#pragma unroll 1
    for (int rep = 0; rep <= REP_GEMM; ++rep) phase_A2b(P, B, l, lds);
    xcd_barrier(xb);
#pragma unroll 1
    for (int rep = 0; rep <= REP_ATTN; ++rep) { phase_attn(P, B, l + 2 * rep, l, lds, &s_item, (int)xb.x, rep ? 2 : -1); if (rep < REP_ATTN) xcd_barrier(xb); }
    xcd_barrier(xb);
#pragma unroll 1
    for (int rep = 0; rep <= REP_GEMM; ++rep) { EpiY e{B}; phase_gemm(B.H, 1024, B.wout + (size_t)l * 1024 * 1024, 1024, 1024, 8, lds, e, false); }
    xcd_barrier(xb);
    phase_D(P, B, l + 1);
    if (l == 0) xcd_barrier(xb);
  }
}

extern "C" void kernel_launch(void* const* d_in, const int* in_sizes, int n_in,
                              void* d_out, int out_size, void* d_ws, size_t ws_size,
                              hipStream_t stream) {
  static int grid_blocks = 0;
  if (!grid_blocks) {
    int dev = 0, cus = 0, per_cu = 0;
    (void)hipGetDevice(&dev);
    (void)hipDeviceGetAttribute(&cus, hipDeviceAttributeMultiprocessorCount, dev);
    (void)hipOccupancyMaxActiveBlocksPerMultiprocessor(&per_cu, fwd_megakernel, 256, 0);
    if (per_cu > 2) per_cu = 2;
    if (per_cu < 1) per_cu = 1;
    grid_blocks = cus * per_cu;
    if (ws_size < WS_END) fprintf(stderr, "workspace too small: %zu < %zu\n", ws_size, (size_t)WS_END);
  }
  Params p{};
  const float** pp = (const float**)&p;
  for (int i = 0; i < 23; ++i) pp[i] = (const float*)d_in[i];
  p.out = (float*)d_out;
  p.ws = (unsigned char*)d_ws;
  (void)hipMemsetAsync((char*)d_ws + WS_CTR, 0, 256 + 16384, stream);
  void* args[] = {&p};
  hipError_t e = hipLaunchCooperativeKernel((void*)fwd_megakernel, dim3(grid_blocks), dim3(256), args, 0, stream);
  if (e != hipSuccess) fprintf(stderr, "cooperative launch failed: %s (grid %d)\n", hipGetErrorString(e), grid_blocks);
}
```

```cpp
#include <hip/hip_runtime.h>
#include <hip/hip_cooperative_groups.h>
#include <cstdio>
#include <cstdint>
namespace cg = cooperative_groups;
#define REP_ATTN 0
#define REP_GEMM 0

typedef unsigned short u16;
typedef unsigned int u32;
using bf16x8 = __attribute__((ext_vector_type(8))) short;
using f32x16 = __attribute__((ext_vector_type(16))) float;
typedef __bf16 bf16x2_t __attribute__((ext_vector_type(2)));
typedef float f32x2_t __attribute__((ext_vector_type(2)));
#define DI __device__ __forceinline__
#define MFMA(a, b, c) __builtin_amdgcn_mfma_f32_32x32x16_bf16((a), (b), (c), 0, 0, 0)

constexpr int NP = 32768, NSM = 128, R = NP + NSM;
constexpr int T_S = 2112;
constexpr float LOG2E = 1.4426950408889634f;
constexpr float QSC = 0.125f * LOG2E;
constexpr float MSC = 0.10206207261596575f * LOG2E;
constexpr float EPSN = 1e-6f;

constexpr size_t O_Y = 0;
constexpr size_t O_PFK = (size_t)R * 1024;
constexpr size_t O_PFV = O_PFK + 16777216;
constexpr size_t O_PLF = O_PFV + 16777216;
constexpr size_t O_PSK = O_PLF + 262144;
constexpr size_t O_PSV = O_PSK + 16777216;
constexpr size_t O_PCKV = O_PSV + 16777216;
constexpr size_t O_PKPE = O_PCKV + 8388608;
constexpr size_t O_SFK = O_PKPE + 2097152;
constexpr size_t O_SFV = O_SFK + 65536;
constexpr size_t O_SLF = O_SFV + 65536;
constexpr size_t O_SSK = O_SLF + 1024;
constexpr size_t O_SSV = O_SSK + 65536;
constexpr size_t O_SCKV = O_SSV + 65536;
constexpr size_t O_SKPE = O_SCKV + 32768;

constexpr size_t al256(size_t x) { return (x + 255) & ~(size_t)255; }
constexpr size_t WS_CTR = 0;
constexpr size_t WS_BAR = 256;
constexpr size_t WS_KMAX = 256 + 14336;
constexpr size_t WS_SILUC = 256 + 16384;
constexpr size_t WS_MOD = WS_SILUC + 16 * 1024 * 4;
constexpr size_t WS_WIN = WS_MOD + 2 * 16 * 3072 * 4;
constexpr size_t WS_WQ = WS_WIN + (size_t)2 * 3072 * 1024 * 2;
constexpr size_t WS_WKV = WS_WQ + (size_t)2 * 768 * 256 * 2;
constexpr size_t WS_WOUT = WS_WKV + (size_t)2 * 1024 * 128 * 2;
constexpr size_t WS_H = WS_WOUT + (size_t)2 * 1024 * 1024 * 2;
constexpr size_t WS_GATE = WS_H + (size_t)R * 1024 * 2;
constexpr size_t WS_QM = WS_GATE + (size_t)R * 1024 * 2;
constexpr size_t WS_TMP32 = WS_QM;
constexpr size_t WS_CQN = WS_QM + (size_t)R * 1024 * 2;
constexpr size_t WS_QF = WS_CQN + (size_t)R * 256 * 2;
constexpr size_t WS_QS = WS_QF + (size_t)R * 256 * 2;
constexpr size_t WS_KF_P = WS_QS + (size_t)R * 256 * 2;
constexpr size_t WS_KS_P = WS_KF_P + (size_t)NP * 256 * 2;
constexpr size_t WS_VFT_P = WS_KS_P + (size_t)NP * 256 * 2;
constexpr size_t WS_VST_P = WS_VFT_P + (size_t)NP * 256 * 2;
constexpr size_t WS_KN_P = WS_VST_P + (size_t)NP * 256 * 2;
constexpr size_t WS_KPE_P = WS_KN_P + (size_t)NP * 512 * 2;
constexpr size_t WS_VM_P = WS_KPE_P + (size_t)NP * 32 * 2;
constexpr size_t WS_CKVN = WS_VM_P + (size_t)NP * 512 * 2;
constexpr size_t WS_KF_S = WS_CKVN + (size_t)R * 128 * 2;
constexpr size_t WS_KS_S = WS_KF_S + (size_t)8 * T_S * 256 * 2;
constexpr size_t WS_VFT_S = WS_KS_S + (size_t)8 * T_S * 256 * 2;
constexpr size_t WS_VST_S = WS_VFT_S + (size_t)8 * T_S * 256 * 2;
constexpr size_t WS_KN_S = WS_VST_S + (size_t)8 * T_S * 256 * 2;
constexpr size_t WS_KPE_S = WS_KN_S + (size_t)8 * T_S * 512 * 2;
constexpr size_t WS_VM_S = WS_KPE_S + (size_t)8 * T_S * 32 * 2;
constexpr size_t WS_CKVC = WS_VM_S + (size_t)8 * T_S * 512 * 2;
constexpr size_t WS_LOGF = WS_CKVC + (size_t)8 * 2048 * 128 * 2;
constexpr size_t WS_FP = WS_LOGF + (size_t)R * 4 * 4;
constexpr size_t WS_FS = WS_FP + (size_t)8 * 4 * 4096 * 4;
constexpr size_t WS_END = WS_FS + (size_t)8 * 4 * T_S * 4;
static_assert((size_t)R * 416 * 4 <= (size_t)R * 1024 * 2 && (size_t)R * 768 * 2 <= (size_t)R * 1024 * 2, "aliases must fit");
static_assert(WS_END < (size_t)530 * 1000 * 1000, "workspace too large");

struct Params {
  const float* x_prompt; const float* x_sample; const float* c_prompt; const float* c_sample;
  const float* cache_fox_k; const float* cache_fox_v; const float* cache_fox_logf;
  const float* cache_sb_k; const float* cache_sb_v; const float* cache_ckv; const float* cache_kpe;
  const float* g_pre; const float* g_post; const float* w_ada; const float* b_ada; const float* w_in;
  const float* b_f; const float* g_q_a; const float* w_uq; const float* g_kv_a; const float* w_uk;
  const float* w_uv; const float* w_out;
  float* out;
  unsigned char* ws;
};

DI u32 pk2(float a, float b) { f32x2_t v = {a, b}; bf16x2_t r = __builtin_convertvector(v, bf16x2_t); return __builtin_bit_cast(u32, r); }
DI u16 bf1(float a) { return (u16)(pk2(a, 0.f) & 0xffffu); }
DI int crow(int i, int hi) { return (i & 3) + 8 * (i >> 2) + 4 * hi; }
DI float wave_sum(float v) {
#pragma unroll
  for (int o = 32; o > 0; o >>= 1) v += __shfl_xor(v, o);
  return v;
}
DI double shfl_up_d(double x, int o) { int lo = __double2loint(x), hi = __double2hiint(x); lo = __shfl_up(lo, o); hi = __shfl_up(hi, o); return __hiloint2double(hi, lo); }
DI int otid() { int t = threadIdx.x; asm volatile("" : "+v"(t)); return t; }
DI float ex2(float x) { return __builtin_amdgcn_exp2f(x); }
DI float lg2(float x) { return __builtin_amdgcn_logf(x); }
DI float silu_f(float v) { return v * __builtin_amdgcn_rcpf(1.f + __expf(-v)); }
DI float halves_sum(float x) { auto rr = __builtin_amdgcn_permlane32_swap(__float_as_uint(x), __float_as_uint(x), false, false); return __uint_as_float(rr[0]) + __uint_as_float(rr[1]); }
DI float halves_max(float x) { auto rr = __builtin_amdgcn_permlane32_swap(__float_as_uint(x), __float_as_uint(x), false, false); return fmaxf(__uint_as_float(rr[0]), __uint_as_float(rr[1])); }
DI void rope_cs(int pos, int fidx, float& c, float& s) {
  const float inv = ex2(-(float)fidx * (13.287712379549449f / 16.f));
  float rev = ((float)pos * inv) * 0.15915494309189535f;
  rev = rev - floorf(rev);
  s = __builtin_amdgcn_sinf(rev); c = __builtin_amdgcn_cosf(rev);
}

struct Bufs {
  u32* ctr; float* siluc; float* mod; u16* win; u16* wq; u16* wkv; u16* wout; u16* H; u16* GATE; u16* QM; u16* Y; float* TMP32;
  u16* CQN; u16* QF; u16* QS; u16* KF_P; u16* KS_P; u16* VFT_P; u16* VST_P; u16* KN_P; u16* KPE_P; u16* VM_P; u16* CKVN;
  u16* KF_S; u16* KS_S; u16* VFT_S; u16* VST_S; u16* KN_S; u16* KPE_S; u16* VM_S; u16* CKVC; float* LOGF; float* FP; float* FS;
};
DI Bufs make_bufs(unsigned char* ws) {
  Bufs B;
  B.ctr = (u32*)(ws + WS_CTR); B.siluc = (float*)(ws + WS_SILUC); B.mod = (float*)(ws + WS_MOD); B.win = (u16*)(ws + WS_WIN);
  B.wq = (u16*)(ws + WS_WQ); B.wkv = (u16*)(ws + WS_WKV); B.wout = (u16*)(ws + WS_WOUT); B.H = (u16*)(ws + WS_H); B.GATE = (u16*)(ws + WS_GATE);
  B.QM = (u16*)(ws + WS_QM); B.Y = (u16*)(ws + WS_QM); B.TMP32 = (float*)(ws + WS_TMP32); B.CQN = (u16*)(ws + WS_CQN);
  B.QF = (u16*)(ws + WS_QF); B.QS = (u16*)(ws + WS_QS); B.KF_P = (u16*)(ws + WS_KF_P); B.KS_P = (u16*)(ws + WS_KS_P);
  B.VFT_P = (u16*)(ws + WS_VFT_P); B.VST_P = (u16*)(ws + WS_VST_P); B.KN_P = (u16*)(ws + WS_KN_P); B.KPE_P = (u16*)(ws + WS_KPE_P); B.VM_P = (u16*)(ws + WS_VM_P); B.CKVN = (u16*)(ws + WS_CKVN);
  B.KF_S = (u16*)(ws + WS_KF_S); B.KS_S = (u16*)(ws + WS_KS_S); B.VFT_S = (u16*)(ws + WS_VFT_S); B.VST_S = (u16*)(ws + WS_VST_S);
  B.KN_S = (u16*)(ws + WS_KN_S); B.KPE_S = (u16*)(ws + WS_KPE_S); B.VM_S = (u16*)(ws + WS_VM_S); B.CKVC = (u16*)(ws + WS_CKVC); B.LOGF = (float*)(ws + WS_LOGF); B.FP = (float*)(ws + WS_FP); B.FS = (float*)(ws + WS_FS);
  return B;
}


#define XB_TMO      128
#define XB_XCNT(j)  (256  + 64 * (j))
#define XB_XSUB(j)  (1280 + 64 * (j))
#define XB_XGEN(j)  (2304 + 64 * (j))
#define XB_TOP      3328
#define XB_TOPGEN   3392
#define XCD_BAR_WORDS 3456
#define XB_SPIN_CAP (1u << 22)
#define LAS __attribute__((address_space(3)))
DI unsigned xb_ld(unsigned* p) { return __hip_atomic_load(p, __ATOMIC_RELAXED, __HIP_MEMORY_SCOPE_AGENT); }
DI unsigned xb_add(unsigned* p, unsigned v) { return __hip_atomic_fetch_add(p, v, __ATOMIC_RELAXED, __HIP_MEMORY_SCOPE_AGENT); }
DI unsigned xb_xcc_id() { return (unsigned)__builtin_amdgcn_s_getreg((3 << 11) | 20) & 0xFu; }
#define XB_SPIN(cond, bar) do { unsigned _sp = 0; while (cond) { __builtin_amdgcn_s_sleep(1); \
    if ((++_sp & 255u) == 0u) { if (xb_ld(&(bar)[XB_TMO])) break; if (_sp > XB_SPIN_CAP) { atomicAdd(&(bar)[XB_TMO], 1u); break; } } } } while (0)
struct XcdBarrier { unsigned* bar; unsigned x; volatile LAS unsigned* st; };
DI XcdBarrier xcd_barrier_post(unsigned* bar, volatile LAS unsigned* st) {
  XcdBarrier b; b.bar = bar; b.x = xb_xcc_id(); b.st = st;
  if (threadIdx.x == 0) (void)xb_add(&bar[XB_XCNT(b.x)], 1u);
  return b;
}
DI void xcd_barrier_complete(unsigned* bar, unsigned x, unsigned& nloc, unsigned& nx) {
  const unsigned G = gridDim.x * gridDim.y * gridDim.z;
  unsigned sum, cnt, mine, sp = 0u;
  for (;;) {
    sum = 0u; cnt = 0u; mine = 0u;
#pragma unroll
    for (unsigned j = 0; j < 16; ++j) { const unsigned c = xb_ld(&bar[XB_XCNT(j)]); sum += c; cnt += (c > 0u) ? 1u : 0u; mine = (j == x) ? c : mine; }
    if (sum == G) break;
    __builtin_amdgcn_s_sleep(1);
    if ((++sp & 255u) == 0u) { if (xb_ld(&bar[XB_TMO])) break; if (sp > XB_SPIN_CAP) { atomicAdd(&bar[XB_TMO], 1u); break; } }
  }
  nloc = mine > 0u ? mine : 1u; nx = cnt > 0u ? cnt : 1u;
}
DI void xcd_barrier(const XcdBarrier& b) {
  asm volatile("s_waitcnt vmcnt(0)" ::: "memory");
  __syncthreads();
  if (threadIdx.x == 0) {
    unsigned* bar = b.bar;
    __builtin_amdgcn_s_waitcnt(0);
    unsigned nloc = b.st[0], nx = b.st[1];
    if (nloc == 0u) { xcd_barrier_complete(bar, b.x, nloc, nx); b.st[0] = nloc; b.st[1] = nx; }
    const unsigned old = xb_add(&bar[XB_XSUB(b.x)], 1u);
    const unsigned gen = old / nloc;
    if (old + 1u == (gen + 1u) * nloc) {
      __builtin_amdgcn_fence(__ATOMIC_RELEASE, "agent");
      asm volatile("s_waitcnt vmcnt(0)" ::: "memory");
      const unsigned og = xb_add(&bar[XB_TOP], 1u);
      const unsigned tg = og / nx;
      if (og + 1u == (tg + 1u) * nx) xb_add(&bar[XB_TOPGEN], 1u);
      else XB_SPIN(xb_ld(&bar[XB_TOPGEN]) == tg, bar);
      __builtin_amdgcn_fence(__ATOMIC_ACQUIRE, "agent");
      xb_add(&bar[XB_XGEN(b.x)], 1u);
      asm volatile("s_waitcnt vmcnt(0)" ::: "memory");
    } else {
      XB_SPIN(xb_ld(&bar[XB_XGEN(b.x)]) == gen, bar);
      __builtin_amdgcn_fence(__ATOMIC_ACQUIRE, "agent");
      asm volatile("s_waitcnt vmcnt(0)" ::: "memory");
    }
  }
  __syncthreads();
}

DI int in_colmap(int n) { return n < 768 ? n : n < 2432 ? n + 4 : n < 2944 ? n + 36 : n < 2976 ? n - 508 : n < 2980 ? n - 2208 : -1; }

DI void phase_prep(const Params& P, const Bufs& B) {
  const size_t gtid = (size_t)blockIdx.x * 256 + otid(), gsz = (size_t)gridDim.x * 256;
  for (size_t i = gtid; i < 16 * 1024; i += gsz) {
    const float c = i < 8192 ? P.c_prompt[i] : P.c_sample[i - 8192];
    B.siluc[i] = c / (1.f + __expf(-c));
  }
  for (size_t i = gtid; i < (size_t)2 * 128 * 3072; i += gsz) {
    const int n = (int)(i % 3072); const int kc = (int)((i / 3072) % 128); const int l = (int)(i / (3072 * 128));
    const int col = in_colmap(n);
    float v[8];
#pragma unroll
    for (int j = 0; j < 8; ++j) v[j] = col >= 0 ? P.w_in[((size_t)l * 1024 + kc * 8 + j) * 2980 + col] : 0.f;
    uint4 o = {pk2(v[0], v[1]), pk2(v[2], v[3]), pk2(v[4], v[5]), pk2(v[6], v[7])};
    *(uint4*)(B.win + ((size_t)l * 3072 + n) * 1024 + kc * 8) = o;
  }
  for (size_t i = gtid; i < (size_t)2 * 128 * 1024; i += gsz) {
    const int n = (int)(i & 1023); const int kc = (int)((i >> 10) & 127); const int l = (int)(i >> 17);
    float v[8];
#pragma unroll
    for (int j = 0; j < 8; ++j) v[j] = P.w_out[((size_t)l * 1024 + kc * 8 + j) * 1024 + n];
    uint4 o = {pk2(v[0], v[1]), pk2(v[2], v[3]), pk2(v[4], v[5]), pk2(v[6], v[7])};
    *(uint4*)(B.wout + ((size_t)l * 1024 + n) * 1024 + kc * 8) = o;
  }
  for (size_t i = gtid; i < (size_t)2 * 32 * 768; i += gsz) {
    const int n = (int)(i % 768); const int kc = (int)((i / 768) & 31); const int l = (int)(i / (768 * 32));
    float v[8];
#pragma unroll
    for (int j = 0; j < 8; ++j) v[j] = P.w_uq[((size_t)l * 256 + kc * 8 + j) * 768 + n];
    uint4 o = {pk2(v[0], v[1]), pk2(v[2], v[3]), pk2(v[4], v[5]), pk2(v[6], v[7])};
    *(uint4*)(B.wq + ((size_t)l * 768 + n) * 256 + kc * 8) = o;
  }
  for (size_t i = gtid; i < (size_t)2 * 16 * 1024; i += gsz) {
    const int n = (int)(i & 1023); const int kc = (int)((i >> 10) & 15); const int l = (int)(i >> 14);
    const float* srcw = (n < 512 ? P.w_uk : P.w_uv) + (size_t)l * 128 * 512 + (n & 511);
    float v[8];
#pragma unroll
    for (int j = 0; j < 8; ++j) v[j] = srcw[(size_t)(kc * 8 + j) * 512];
    uint4 o = {pk2(v[0], v[1]), pk2(v[2], v[3]), pk2(v[4], v[5]), pk2(v[6], v[7])};
    *(uint4*)(B.wkv + ((size_t)l * 1024 + n) * 128 + kc * 8) = o;
  }
}

DI void phase_mod(const Params& P, const Bufs& B, char* lds) {
  float* sc = (float*)lds;
  const int tid = otid();
  for (int u = blockIdx.x; u < 192; u += gridDim.x) {
    const int l = u / 96, j0 = (u % 96) * 32;
    __syncthreads();
    for (int i = tid; i < 16 * 1024 / 4; i += 256) ((float4*)sc)[i] = ((const float4*)B.siluc)[i];
    __syncthreads();
    const int jj = tid & 31, kq = tid >> 5;
    float acc[16];
#pragma unroll
    for (int i = 0; i < 16; ++i) acc[i] = 0.f;
    const float* wp = P.w_ada + ((size_t)l * 1024 + kq * 128) * 3072 + j0 + jj;
#pragma unroll 4
    for (int k = 0; k < 128; ++k) {
      const float wv = wp[(size_t)k * 3072];
#pragma unroll
      for (int i = 0; i < 16; ++i) acc[i] += sc[i * 1024 + kq * 128 + k] * wv;
    }
    __syncthreads();
    float* red = (float*)lds;
#pragma unroll
    for (int i = 0; i < 16; ++i) red[(kq * 16 + i) * 32 + jj] = acc[i];
    __syncthreads();
    for (int o = tid; o < 512; o += 256) {
      const int i = o >> 5, j = o & 31;
      float s = 0.f;
#pragma unroll
      for (int q = 0; q < 8; ++q) s += red[(q * 16 + i) * 32 + j];
      B.mod[((size_t)l * 16 + i) * 3072 + j0 + j] = s + P.b_ada[l * 3072 + j0 + j];
    }
  }
  __syncthreads();
}

DI void phase_D(const Params& P, const Bufs& B, int l) {
  const int tid_ = otid(); const int lane = tid_ & 63, w = tid_ >> 6;
  for (int row0 = (blockIdx.x * 4 + w) * 2; row0 < R; row0 += gridDim.x * 8) {
    float4 xv[2][4];
    int mi[2];
#pragma unroll
    for (int r = 0; r < 2; ++r) { const int row = row0 + r; mi[r] = row < NP ? (row >> 12) : 8 + ((row - NP) >> 4); }
    if (l == 0) {
#pragma unroll
      for (int r = 0; r < 2; ++r) {
        const int row = row0 + r;
        const float* xin = row < NP ? P.x_prompt + (size_t)row * 1024 : P.x_sample + (size_t)(row - NP) * 1024;
#pragma unroll
        for (int j = 0; j < 4; ++j) xv[r][j] = ((const float4*)xin)[j * 64 + lane];
      }
    } else {
      uint2 yb[2][4]; float4 xo[2][4];
#pragma unroll
      for (int r = 0; r < 2; ++r) {
        const int row = row0 + r;
        const float* xin = row < NP ? P.x_prompt + (size_t)row * 1024 : P.x_sample + (size_t)(row - NP) * 1024;
        const float* xp = (l == 1) ? xin : P.out + O_Y + (size_t)row * 1024;
        const u16* Yr = B.Y + (size_t)row * 1024;
#pragma unroll
        for (int j = 0; j < 4; ++j) { yb[r][j] = ((const uint2*)Yr)[j * 64 + lane]; xo[r][j] = ((const float4*)xp)[j * 64 + lane]; }
      }
      const float* gp = P.g_post + (size_t)(l - 1) * 1024;
#pragma unroll
      for (int r = 0; r < 2; ++r) {
        const int row = row0 + r;
        float4 yv[4]; float ss = 0.f;
#pragma unroll
        for (int j = 0; j < 4; ++j) {
          yv[j].x = __uint_as_float(yb[r][j].x << 16); yv[j].y = __uint_as_float(yb[r][j].x & 0xffff0000u);
          yv[j].z = __uint_as_float(yb[r][j].y << 16); yv[j].w = __uint_as_float(yb[r][j].y & 0xffff0000u);
          ss += yv[j].x * yv[j].x + yv[j].y * yv[j].y + yv[j].z * yv[j].z + yv[j].w * yv[j].w;
        }
        ss = wave_sum(ss);
        const float rs = rsqrtf(ss * (1.f / 1024.f) + EPSN);
        const float* gate = B.mod + ((size_t)(l - 1) * 16 + mi[r]) * 3072 + 2048;
        float* orow = P.out + O_Y + (size_t)row * 1024;
#pragma unroll
        for (int j = 0; j < 4; ++j) {
          const float4 g = ((const float4*)gate)[j * 64 + lane];
          const float4 q = ((const float4*)gp)[j * 64 + lane];
          xv[r][j].x = xo[r][j].x + g.x * (yv[j].x * rs * q.x); xv[r][j].y = xo[r][j].y + g.y * (yv[j].y * rs * q.y);
          xv[r][j].z = xo[r][j].z + g.z * (yv[j].z * rs * q.z); xv[r][j].w = xo[r][j].w + g.w * (yv[j].w * rs * q.w);
          ((float4*)orow)[j * 64 + lane] = xv[r][j];
        }
      }
    }
    if (l < 2) {
      const float* gp = P.g_pre + (size_t)l * 1024;
#pragma unroll
      for (int r = 0; r < 2; ++r) {
        const int row = row0 + r;
        float ss = 0.f;
#pragma unroll
        for (int j = 0; j < 4; ++j) ss += xv[r][j].x * xv[r][j].x + xv[r][j].y * xv[r][j].y + xv[r][j].z * xv[r][j].z + xv[r][j].w * xv[r][j].w;
        ss = wave_sum(ss);
        const float rs = rsqrtf(ss * (1.f / 1024.f) + EPSN);
        const float* md = B.mod + ((size_t)l * 16 + mi[r]) * 3072;
#pragma unroll
        for (int j = 0; j < 4; ++j) {
          const float4 sh = ((const float4*)md)[j * 64 + lane];
          const float4 scl = ((const float4*)(md + 1024))[j * 64 + lane];
          const float4 g = ((const float4*)gp)[j * 64 + lane];
          const float h0 = xv[r][j].x * rs * g.x * (1.f + scl.x) + sh.x, h1 = xv[r][j].y * rs * g.y * (1.f + scl.y) + sh.y;
          const float h2 = xv[r][j].z * rs * g.z * (1.f + scl.z) + sh.z, h3 = xv[r][j].w * rs * g.w * (1.f + scl.w) + sh.w;
          *(uint2*)(B.H + (size_t)row * 1024 + (j * 64 + lane) * 4) = make_uint2(pk2(h0, h1), pk2(h2, h3));
        }
      }
    }
  }
}

constexpr int GP = 72;
template <class Epi, bool SW>
DI void gemm_tile(const u16* __restrict__ A, int lda, const u16* __restrict__ Bt, int ldb, int K, int m0, int n0, char* lds, const Epi& epi) {
  const int tid = otid(), lane = tid & 63, w = tid >> 6, r32 = lane & 31, hi = lane >> 5;
  const int wm = w >> 1, wn = w & 1;
  u16* As0 = (u16*)lds; u16* Bs0 = As0 + 2 * 128 * GP;
  f32x16 acc00, acc01, acc10, acc11;
#pragma unroll
  for (int i = 0; i < 16; ++i) { acc00[i] = 0.f; acc01[i] = 0.f; acc10[i] = 0.f; acc11[i] = 0.f; }
  const int srow = tid >> 3, skc = tid & 7;
  const u16* Ag = A + (size_t)(m0 + srow) * lda + skc * 8;
  const u16* Bg = Bt + (size_t)(n0 + srow) * ldb + skc * 8;
  const size_t a32 = (size_t)32 * lda, b32 = (size_t)32 * ldb;
  uint4 pa0, pa1, pa2, pa3, pb0, pb1, pb2, pb3;
  uint4 qa0, qa1, qa2, qa3, qb0, qb1, qb2, qb3;
#define GLOAD(S, kt_) { const int ko_ = (kt_) * 64; \
    S##a0 = *(const uint4*)(Ag + ko_); S##a1 = *(const uint4*)(Ag + a32 + ko_); S##a2 = *(const uint4*)(Ag + 2 * a32 + ko_); S##a3 = *(const uint4*)(Ag + 3 * a32 + ko_); \
    S##b0 = *(const uint4*)(Bg + ko_); S##b1 = *(const uint4*)(Bg + b32 + ko_); S##b2 = *(const uint4*)(Bg + 2 * b32 + ko_); S##b3 = *(const uint4*)(Bg + 3 * b32 + ko_); }
#define GSTORE(S, st_) { u16* Aw = As0 + (st_) * 128 * GP + srow * GP + skc * 8; u16* Bw = Bs0 + (st_) * 128 * GP + srow * GP + skc * 8; \
    *(uint4*)(Aw) = S##a0; *(uint4*)(Aw + 32 * GP) = S##a1; *(uint4*)(Aw + 64 * GP) = S##a2; *(uint4*)(Aw + 96 * GP) = S##a3; \
    *(uint4*)(Bw) = S##b0; *(uint4*)(Bw + 32 * GP) = S##b1; *(uint4*)(Bw + 64 * GP) = S##b2; *(uint4*)(Bw + 96 * GP) = S##b3; }
#define GCOMPUTE(st_) { const u16* As = As0 + (st_) * 128 * GP; const u16* Bs = Bs0 + (st_) * 128 * GP; __builtin_amdgcn_s_setprio(3); \
    _Pragma("unroll") for (int ks = 0; ks < 4; ++ks) { \
      const bf16x8 a0 = *(const bf16x8*)(As + (wm * 64 + r32) * GP + ks * 16 + hi * 8); \
      const bf16x8 a1 = *(const bf16x8*)(As + (wm * 64 + 32 + r32) * GP + ks * 16 + hi * 8); \
      const bf16x8 b0 = *(const bf16x8*)(Bs + (wn * 64 + r32) * GP + ks * 16 + hi * 8); \
      const bf16x8 b1 = *(const bf16x8*)(Bs + (wn * 64 + 32 + r32) * GP + ks * 16 + hi * 8); \
      if (SW) { acc00 = MFMA(b0, a0, acc00); acc01 = MFMA(b1, a0, acc01); acc10 = MFMA(b0, a1, acc10); acc11 = MFMA(b1, a1, acc11); } \
      else { acc00 = MFMA(a0, b0, acc00); acc01 = MFMA(a0, b1, acc01); acc10 = MFMA(a1, b0, acc10); acc11 = MFMA(a1, b1, acc11); } } __builtin_amdgcn_s_setprio(0); }
  const int nk = K >> 6;
  GLOAD(p, 0)
  GLOAD(q, 1)
  GSTORE(p, 0)
  __syncthreads();
  for (int kt = 0; kt < nk; kt += 2) {
    if (kt + 2 < nk) GLOAD(p, kt + 2)
    __builtin_amdgcn_sched_barrier(0);
    GCOMPUTE(0)
    GSTORE(q, 1)
    __syncthreads();
    if (kt + 3 < nk) GLOAD(q, kt + 3)
    __builtin_amdgcn_sched_barrier(0);
    GCOMPUTE(1)
    if (kt + 2 < nk) GSTORE(p, 0)
    __syncthreads();
  }
#undef GLOAD
#undef GSTORE
#undef GCOMPUTE
  epi.template run<SW>(m0 + wm * 64, n0 + wn * 64, acc00, r32, hi);
  epi.template run<SW>(m0 + wm * 64, n0 + wn * 64 + 32, acc01, r32, hi);
  epi.template run<SW>(m0 + wm * 64 + 32, n0 + wn * 64, acc10, r32, hi);
  epi.template run<SW>(m0 + wm * 64 + 32, n0 + wn * 64 + 32, acc11, r32, hi);
}

struct EpiIn {
  const Params& P; const Bufs& B; int l;
  template <bool SW>
  DI void run(int rowbase, int colbase, const f32x16 v, int r32, int hi) const {
    const bool samp = rowbase >= NP;
    if (!SW) {
      const u32 rb = (u32)rowbase + 4u * hi;
      const int seg = colbase >> 8; const u32 c = (colbase & 255) + r32;
      const int grp = seg >> 2;
      const u32 ob = samp ? rb - NP : rb;
      float* o = P.out + (samp ? (grp ? O_SSV : O_SFV) + (size_t)l * 32768 : (grp ? O_PSV : O_PFV) + (size_t)l * 8388608) + ob * 256u + c;
      u16* Vb = (u16*)(P.ws + (samp ? (grp ? WS_VST_S : WS_VFT_S) : (grp ? WS_VST_P : WS_VFT_P)));
#pragma unroll
      for (int g = 0; g < 4; ++g) {
#pragma unroll
        for (int j = 0; j < 4; ++j) o[(8 * g + j) * 256] = v[4 * g + j];
        const u32 row0 = rb + 8 * g, orow0 = ob + 8 * g;
        const u32 bb = samp ? (orow0 >> 4) : (row0 >> 12);
        const u32 t0 = samp ? 2048u + (orow0 & 15u) : (row0 & 4095u);
        const u32 T = samp ? T_S : 4096;
        uint2 pkv = {pk2(v[4 * g], v[4 * g + 1]), pk2(v[4 * g + 2], v[4 * g + 3])};
        *(uint2*)(Vb + ((bb * 256u + c) * T + t0)) = pkv;
      }
      return;
    }
    const u32 tok = (u32)rowbase + r32;
    const u32 otok = samp ? tok - NP : tok;
    if (colbase < 2048) {
      const int seg = colbase >> 8; const u32 c0 = (colbase & 255) + 4u * hi;
      const int kind = seg & 3, grp = seg >> 2;
      if (kind == 0) {
        u16* Q = (u16*)(P.ws + (grp ? WS_QS : WS_QF)) + tok * 256u + c0;
#pragma unroll
        for (int g = 0; g < 4; ++g) *(uint2*)(Q + 8 * g) = make_uint2(pk2(v[4 * g] * QSC, v[4 * g + 1] * QSC), pk2(v[4 * g + 2] * QSC, v[4 * g + 3] * QSC));
      } else if (kind == 1) {
        float* o = P.out + (samp ? (grp ? O_SSK : O_SFK) + (size_t)l * 32768 : (grp ? O_PSK : O_PFK) + (size_t)l * 8388608) + otok * 256u + c0;
        const u32 krow_ = samp ? ((otok >> 4) * T_S + 2048u + (otok & 15u)) : tok;
        u16* Kb = (u16*)(P.ws + (samp ? (grp ? WS_KS_S : WS_KF_S) : (grp ? WS_KS_P : WS_KF_P))) + krow_ * 256u + c0;
#pragma unroll
        for (int g = 0; g < 4; ++g) {
          *(float4*)(o + 8 * g) = make_float4(v[4 * g], v[4 * g + 1], v[4 * g + 2], v[4 * g + 3]);
          *(uint2*)(Kb + 8 * g) = make_uint2(pk2(v[4 * g], v[4 * g + 1]), pk2(v[4 * g + 2], v[4 * g + 3]));
        }
        if (grp == 0 && !samp) {
          float ss = 0.f;
#pragma unroll
          for (int i = 0; i < 16; ++i) ss += v[i] * v[i];
#pragma unroll
          for (int o2 = 16; o2 > 0; o2 >>= 1) ss = fmaxf(ss, __shfl_xor(ss, o2));
          if (r32 == 0) {
            const int hh_ = (colbase & 255) >> 6, part = ((colbase >> 5) & 1) * 2 + hi, bb_ = rowbase >> 12;
            atomicMax((u32*)(P.ws + WS_KMAX) + ((l * 8 + bb_) * 4 + hh_) * 4 + part, __float_as_uint(ss));
          }
        }
      } else {
        u16* G = B.GATE + tok * 1024u + grp * 256 + c0;
#pragma unroll
        for (int g = 0; g < 4; ++g) *(uint2*)(G + 8 * g) = make_uint2(pk2(silu_f(v[4 * g]), silu_f(v[4 * g + 1])), pk2(silu_f(v[4 * g + 2]), silu_f(v[4 * g + 3])));
      }
    } else if (colbase < 2432 || colbase == 2944) {
      float* Tp = B.TMP32 + tok * 416u + (colbase == 2944 ? 384 : colbase - 2048) + 4 * hi;
#pragma unroll
      for (int g = 0; g < 4; ++g) *(float4*)(Tp + 8 * g) = make_float4(v[4 * g], v[4 * g + 1], v[4 * g + 2], v[4 * g + 3]);
    } else if (colbase < 2944) {
      u16* G = B.GATE + tok * 1024u + 512 + (colbase - 2432) + 4 * hi;
#pragma unroll
      for (int g = 0; g < 4; ++g) *(uint2*)(G + 8 * g) = make_uint2(pk2(silu_f(v[4 * g]), silu_f(v[4 * g + 1])), pk2(silu_f(v[4 * g + 2]), silu_f(v[4 * g + 3])));
    } else if (colbase == 2976) {
      if (hi == 0) {
        float lf[4];
#pragma unroll
        for (int j = 0; j < 4; ++j) { const float x = v[j] + P.b_f[l * 4 + j]; lf[j] = fminf(x, 0.f) - __logf(1.f + __expf(-fabsf(x))); }
        const float4 o4 = make_float4(lf[0], lf[1], lf[2], lf[3]);
        *(float4*)(P.out + (samp ? O_SLF + (size_t)l * 512 : O_PLF + (size_t)l * 131072) + otok * 4u) = o4;
        *(float4*)(B.LOGF + tok * 4u) = o4;
      }
    }
  }
};

struct EpiQ {
  const Bufs& B;
  template <bool SW>
  DI void run(int rowbase, int colbase, const f32x16 v, int r32, int hi) const {
    const int within = colbase % 96;
    const u32 tok = (u32)rowbase + r32;
    u16* Q = B.QM + tok * 768u + colbase + 4 * hi;
    if (within < 64) {
#pragma unroll
      for (int g = 0; g < 4; ++g) *(uint2*)(Q + 8 * g) = make_uint2(pk2(v[4 * g] * MSC, v[4 * g + 1] * MSC), pk2(v[4 * g + 2] * MSC, v[4 * g + 3] * MSC));
    } else {
      const int pos = tok < NP ? (int)(tok & 4095u) : 2048 + (int)((tok - NP) & 15u);
#pragma unroll
      for (int g = 0; g < 2; ++g) {
        float o1[4], o2[4];
#pragma unroll
        for (int j = 0; j < 4; ++j) {
          float c, s; rope_cs(pos, 8 * g + 4 * hi + j, c, s);
          const float x1 = v[4 * g + j], x2 = v[4 * (g + 2) + j];
          o1[j] = (x1 * c - x2 * s) * MSC; o2[j] = (x2 * c + x1 * s) * MSC;
        }
        *(uint2*)(Q + 8 * g) = make_uint2(pk2(o1[0], o1[1]), pk2(o1[2], o1[3]));
        *(uint2*)(Q + 8 * (g + 2)) = make_uint2(pk2(o2[0], o2[1]), pk2(o2[2], o2[3]));
      }
    }
  }
};

struct EpiKV {
  const Params& P; int cache;
  template <bool SW>
  DI void run(int rowbase, int colbase, const f32x16 v, int r32, int hi) const {
    if (SW) {
      const u32 tok = (u32)rowbase + r32;
      u32 krow_; size_t base;
      if (cache) { krow_ = (tok >> 11) * T_S + (tok & 2047u); base = WS_KN_S; }
      else if (tok >= NP) { const u32 ot = tok - NP; krow_ = (ot >> 4) * T_S + 2048u + (ot & 15u); base = WS_KN_S; }
      else { krow_ = tok; base = WS_KN_P; }
      u16* Kp = (u16*)(P.ws + base) + krow_ * 512u + colbase + 4 * hi;
#pragma unroll
      for (int g = 0; g < 4; ++g) *(uint2*)(Kp + 8 * g) = make_uint2(pk2(v[4 * g], v[4 * g + 1]), pk2(v[4 * g + 2], v[4 * g + 3]));
    } else {
      const u32 c = (u32)(colbase - 512) + r32;
      const u32 rb = (u32)rowbase + 4u * hi;
#pragma unroll
      for (int g = 0; g < 4; ++g) {
        const u32 row0 = rb + 8 * g;
        u32 bb, t0, T; size_t base;
        if (cache) { bb = row0 >> 11; t0 = row0 & 2047u; T = T_S; base = WS_VM_S; }
        else if (row0 >= NP) { const u32 ot = row0 - NP; bb = ot >> 4; t0 = 2048u + (ot & 15u); T = T_S; base = WS_VM_S; }
        else { bb = row0 >> 12; t0 = row0 & 4095u; T = 4096; base = WS_VM_P; }
        *(uint2*)((u16*)(P.ws + base) + ((bb * 512u + c) * T + t0)) = make_uint2(pk2(v[4 * g], v[4 * g + 1]), pk2(v[4 * g + 2], v[4 * g + 3]));
      }
    }
  }
};

struct EpiY {
  const Bufs& B;
  template <bool SW>
  DI void run(int rowbase, int colbase, const f32x16 v, int r32, int hi) const {
    u16* Yp = B.Y + ((u32)rowbase + r32) * 1024u + colbase + 4 * hi;
#pragma unroll
    for (int g = 0; g < 4; ++g) *(uint2*)(Yp + 8 * g) = make_uint2(pk2(v[4 * g], v[4 * g + 1]), pk2(v[4 * g + 2], v[4 * g + 3]));
  }
};

template <class Epi>
DI void phase_gemm(const u16* A, int lda, const u16* Bt, int ldb, int K, int ntn, char* lds, const Epi& epi, bool vsplit) {
  const int x = blockIdx.x & 7, j = blockIdx.x >> 3, nb = gridDim.x >> 3;
  if (ntn == 24) {
    const int nmt = (x >> 2) ? 129 : 128;
    for (int q = j; q < nmt * 6; q += nb) {
      const int ml = q / 6, nl = q - ml * 6;
      const int mt = (x >> 2) * 128 + ml, nt = (x & 3) * 6 + nl;
      if (vsplit && ((nt & 6) == 4) && nt < 16) gemm_tile<Epi, false>(A, lda, Bt, ldb, K, mt * 128, nt * 128, lds, epi);
      else gemm_tile<Epi, true>(A, lda, Bt, ldb, K, mt * 128, nt * 128, lds, epi);
    }
  } else {
    const int nmt = (x == 0) ? 33 : 32;
    for (int q = j; q < nmt * ntn; q += nb) {
      const int ml = q / ntn, nl = q - ml * ntn;
      const int mt = (ml < 32) ? x * 32 + ml : 256;
      gemm_tile<Epi, true>(A, lda, Bt, ldb, K, mt * 128, nl * 128, lds, epi);
    }
  }
}

DI void phase_A2b(const Params& P, const Bufs& B, int l, char* lds) {
  constexpr int NQ = (R / 128) * 6, NKV = (R / 128) * 8, NKC = 128 * 8;
  const EpiQ eq{B}; const EpiKV ekv{P, 0}; const EpiKV ekc{P, 1};
  const u16* wq = B.wq + (size_t)l * 768 * 256; const u16* wkv = B.wkv + (size_t)l * 1024 * 128;
  for (int t = blockIdx.x; t < NQ + NKV + NKC; t += gridDim.x) {
    if (t < NQ) { const int mt = t / 6, nt = t - mt * 6; gemm_tile<EpiQ, true>(B.CQN, 256, wq, 256, 256, mt * 128, nt * 128, lds, eq); }
    else if (t < NQ + NKV) {
      const int u = t - NQ; const int mt = u >> 3, nt = u & 7;
      if (nt < 4) gemm_tile<EpiKV, true>(B.CKVN, 128, wkv, 128, 128, mt * 128, nt * 128, lds, ekv);
      else gemm_tile<EpiKV, false>(B.CKVN, 128, wkv, 128, 128, mt * 128, nt * 128, lds, ekv);
    } else {
      const int u = t - NQ - NKV; const int mt = u >> 3, nt = u & 7;
      if (nt < 4) gemm_tile<EpiKV, true>(B.CKVC, 128, wkv, 128, 128, mt * 128, nt * 128, lds, ekc);
      else gemm_tile<EpiKV, false>(B.CKVC, 128, wkv, 128, 128, mt * 128, nt * 128, lds, ekc);
    }
  }
}

DI void phase_A2a(const Params& P, const Bufs& B, int l, char* lds) {
  const int tid = otid(), lane = tid & 63, w = tid >> 6;
  if (blockIdx.x < 16) {
    const int itb = blockIdx.x; const bool sp = itb >= 8; const int b = itb & 7;
    const int per = sp ? 9 : 16, total = sp ? 2064 : 4096, TT = sp ? T_S : 4096;
    const float4* c4 = (const float4*)(P.cache_fox_logf + ((size_t)l * 8 + b) * 2048 * 4);
    const float4* n4 = (const float4*)(B.LOGF + (sp ? ((size_t)NP + b * 16) * 4 : (size_t)b * 4096 * 4));
    const float4 zz = {0.f, 0.f, 0.f, 0.f};
    float4 v0 = zz, v1 = zz, v2 = zz, v3 = zz, v4 = zz, v5 = zz, v6 = zz, v7 = zz, v8 = zz, v9 = zz, v10 = zz, v11 = zz, v12 = zz, v13 = zz, v14 = zz, v15 = zz;
    double s0 = 0, s1 = 0, s2 = 0, s3 = 0;
#define FLD(i) if (i < per) { const int t = tid * per + i; if (t < total) v##i = sp ? (t < 2048 ? c4[t] : n4[t - 2048]) : n4[t]; s0 += v##i.x; s1 += v##i.y; s2 += v##i.z; s3 += v##i.w; }
    FLD(0) FLD(1) FLD(2) FLD(3) FLD(4) FLD(5) FLD(6) FLD(7) FLD(8) FLD(9) FLD(10) FLD(11) FLD(12) FLD(13) FLD(14) FLD(15)
#undef FLD
    double e0 = s0, e1 = s1, e2 = s2, e3 = s3;
#pragma unroll
    for (int o = 1; o < 64; o <<= 1) {
      const double t0 = shfl_up_d(e0, o), t1 = shfl_up_d(e1, o), t2 = shfl_up_d(e2, o), t3 = shfl_up_d(e3, o);
      if (lane >= o) { e0 += t0; e1 += t1; e2 += t2; e3 += t3; }
    }
    double* wt = (double*)lds;
    __syncthreads();
    if (lane == 63) { wt[w * 4 + 0] = e0; wt[w * 4 + 1] = e1; wt[w * 4 + 2] = e2; wt[w * 4 + 3] = e3; }
    __syncthreads();
    double r0 = e0 - s0, r1 = e1 - s1, r2 = e2 - s2, r3 = e3 - s3;
    for (int q = 0; q < w; ++q) { r0 += wt[q * 4 + 0]; r1 += wt[q * 4 + 1]; r2 += wt[q * 4 + 2]; r3 += wt[q * 4 + 3]; }
    float* d0 = (float*)(P.ws + (sp ? WS_FS : WS_FP)) + (size_t)b * 4 * TT;
#define FST(i) if (i < per) { const int t = tid * per + i; r0 += v##i.x; r1 += v##i.y; r2 += v##i.z; r3 += v##i.w; \
      if (t < TT) { d0[t] = (float)(r0 * (double)LOG2E); d0[TT + t] = (float)(r1 * (double)LOG2E); d0[2 * TT + t] = (float)(r2 * (double)LOG2E); d0[3 * TT + t] = (float)(r3 * (double)LOG2E); } }
    FST(0) FST(1) FST(2) FST(3) FST(4) FST(5) FST(6) FST(7) FST(8) FST(9) FST(10) FST(11) FST(12) FST(13) FST(14) FST(15)
#undef FST
    __syncthreads();
  }
  for (int g = blockIdx.x * 4 + w; g < R / 4; g += gridDim.x * 4) {
    const int row0 = g * 4;
    const bool samp = row0 >= NP;
    const int orow0 = samp ? row0 - NP : row0;
    const int bb = samp ? (orow0 >> 4) : (row0 >> 12);
    const int t0 = samp ? 2048 + (orow0 & 15) : (row0 & 4095);
    const int T = samp ? T_S : 4096;
    const size_t km0 = samp ? (size_t)bb * T_S + t0 : (size_t)row0;
    u16* KPE = (u16*)(P.ws + (samp ? WS_KPE_S : WS_KPE_P));
    const float4 gq = ((const float4*)(P.g_q_a + l * 256))[lane];
#pragma unroll
    for (int j = 0; j < 4; ++j) {
      const float4 v = *(const float4*)(B.TMP32 + (size_t)(row0 + j) * 416 + lane * 4);
      const float ss = wave_sum(v.x * v.x + v.y * v.y + v.z * v.z + v.w * v.w);
      const float rs = rsqrtf(ss * (1.f / 256.f) + EPSN);
      uint2 o = {pk2(v.x * rs * gq.x, v.y * rs * gq.y), pk2(v.z * rs * gq.z, v.w * rs * gq.w)};
      *(uint2*)(B.CQN + (size_t)(row0 + j) * 256 + lane * 4) = o;
    }
    const float2 gk = ((const float2*)(P.g_kv_a + l * 128))[lane];
    float* ockv = P.out + (samp ? O_SCKV + (size_t)l * 16384 : O_PCKV + (size_t)l * 4194304);
    float n0[4], n1[4];
#pragma unroll
    for (int j = 0; j < 4; ++j) {
      const float2 v = *(const float2*)(B.TMP32 + (size_t)(row0 + j) * 416 + 256 + lane * 2);
      const float ss = wave_sum(v.x * v.x + v.y * v.y);
      const float rs = rsqrtf(ss * (1.f / 128.f) + EPSN);
      n0[j] = v.x * rs * gk.x; n1[j] = v.y * rs * gk.y;
      float2 o = {n0[j], n1[j]};
      *(float2*)(ockv + (size_t)(orow0 + j) * 128 + lane * 2) = o;
      *(u32*)(B.CKVN + (size_t)(row0 + j) * 128 + lane * 2) = pk2(n0[j], n1[j]);
    }
    {
      const int j = lane >> 4, i = lane & 15;
      const float x1 = B.TMP32[(size_t)(row0 + j) * 416 + 384 + i], x2 = B.TMP32[(size_t)(row0 + j) * 416 + 400 + i];
      float c, s; rope_cs(t0 + j, i, c, s);
      const float o1 = x1 * c - x2 * s, o2 = x2 * c + x1 * s;
      float* okpe = P.out + (samp ? O_SKPE + (size_t)l * 4096 : O_PKPE + (size_t)l * 1048576);
      okpe[(size_t)(orow0 + j) * 32 + i] = o1; okpe[(size_t)(orow0 + j) * 32 + 16 + i] = o2;
      KPE[(km0 + j) * 32 + i] = bf1(o1); KPE[(km0 + j) * 32 + 16 + i] = bf1(o2);
    }
  }
  const size_t gtid = (size_t)blockIdx.x * 256 + tid, gsz = (size_t)gridDim.x * 256;
  for (size_t i = gtid; i < (size_t)2 * 8 * 2048 * 32; i += gsz) {
    const int which = (int)(i >> 19); const size_t r = i & 524287; const int cc = (int)(r & 31); const int bt = (int)(r >> 5);
    const int b = bt >> 11, t = bt & 2047;
    const float* src = (which ? P.cache_sb_k : P.cache_fox_k) + (((size_t)l * 8 + b) * 2048 + t) * 256 + cc * 8;
    const float4 v0 = ((const float4*)src)[0], v1 = ((const float4*)src)[1];
    uint4 o = {pk2(v0.x, v0.y), pk2(v0.z, v0.w), pk2(v1.x, v1.y), pk2(v1.z, v1.w)};
    *(uint4*)((u16*)(P.ws + (which ? WS_KS_S : WS_KF_S)) + ((size_t)b * T_S + t) * 256 + cc * 8) = o;
  }
  for (size_t i = gtid; i < (size_t)8 * 2048 * 20; i += gsz) {
    const int cc = (int)(i % 20); const int bt = (int)(i / 20); const int b = bt >> 11, t = bt & 2047;
    const float* srcp = cc < 16 ? P.cache_ckv + (((size_t)l * 8 + b) * 2048 + t) * 128 + cc * 8 : P.cache_kpe + (((size_t)l * 8 + b) * 2048 + t) * 32 + (cc - 16) * 8;
    const float4 v0 = ((const float4*)srcp)[0], v1 = ((const float4*)srcp)[1];
    uint4 o = {pk2(v0.x, v0.y), pk2(v0.z, v0.w), pk2(v1.x, v1.y), pk2(v1.z, v1.w)};
    if (cc < 16) *(uint4*)(B.CKVC + (size_t)bt * 128 + cc * 8) = o;
    else *(uint4*)(B.KPE_S + ((size_t)b * T_S + t) * 32 + (cc - 16) * 8) = o;
  }
  for (size_t i = gtid; i < (size_t)2 * 8 * 256 * 256; i += gsz) {
    const int which = (int)(i >> 19); const size_t r = i & 524287; const int hd = (int)(r & 255); const int t8 = (int)((r >> 8) & 255); const int b = (int)(r >> 16);
    const float* src = (which ? P.cache_sb_v : P.cache_fox_v) + (((size_t)l * 8 + b) * 2048 + t8 * 8) * 256 + hd;
    float v[8];
#pragma unroll
    for (int j = 0; j < 8; ++j) v[j] = src[(size_t)j * 256];
    uint4 o = {pk2(v[0], v[1]), pk2(v[2], v[3]), pk2(v[4], v[5]), pk2(v[6], v[7])};
    *(uint4*)((u16*)(P.ws + (which ? WS_VST_S : WS_VFT_S)) + ((size_t)b * 256 + hd) * T_S + t8 * 8) = o;
  }
  const uint4 z4 = {0u, 0u, 0u, 0u};
  for (size_t i = gtid; i < (size_t)8 * 48 * 32; i += gsz) {
    const int cc = (int)(i & 31); const int r = (int)((i >> 5) % 48); const int b = (int)(i / (48 * 32));
    *(uint4*)(B.KF_S + ((size_t)b * T_S + 2064 + r) * 256 + cc * 8) = z4;
    *(uint4*)(B.KS_S + ((size_t)b * T_S + 2064 + r) * 256 + cc * 8) = z4;
  }
  for (size_t i = gtid; i < (size_t)8 * 48 * 68; i += gsz) {
    const int cc = (int)(i % 68); const int r = (int)((i / 68) % 48); const int b = (int)(i / (48 * 68));
    if (cc < 64) *(uint4*)(B.KN_S + ((size_t)b * T_S + 2064 + r) * 512 + cc * 8) = z4;
    else *(uint4*)(B.KPE_S + ((size_t)b * T_S + 2064 + r) * 32 + (cc - 64) * 8) = z4;
  }
  for (size_t i = gtid; i < (size_t)8 * 512 * 6; i += gsz) {
    const int cc = (int)(i % 6); const int rr = (int)(i / 6);
    *(uint4*)(B.VM_S + (size_t)rr * T_S + 2064 + cc * 8) = z4;
    if (rr < 8 * 256) { *(uint4*)(B.VFT_S + (size_t)rr * T_S + 2064 + cc * 8) = z4; *(uint4*)(B.VST_S + (size_t)rr * T_S + 2064 + cc * 8) = z4; }
  }
}

typedef short v4i16_t __attribute__((ext_vector_type(4)));
DI uint2 lds_tr16(const u16* p) {
  const v4i16_t r = __builtin_amdgcn_ds_read_tr16_b64_v4i16((LAS v4i16_t*)(unsigned)(uintptr_t)p);
  return __builtin_bit_cast(uint2, r);
}
template <int TYPE>
DI void attn_item(const Params& P, const Bufs& B, int l, bool samp, int b, int hh, int qt, char* lds) {
  constexpr int DK = (TYPE == 2) ? 96 : 64, DV = 64;
  constexpr int KP = DK + 8, VP = 68;
  constexpr int NKC = 64 * DK / 8 / 256;
  constexpr int NVC = 2;
  constexpr int NDT = DV / 32;
  constexpr int NST = DK / 16;
  constexpr int STG = 64 * KP * 2 + 64 * VP * 2 + 256;
  const int tid = otid(), lane = tid & 63, w = tid >> 6, r32 = lane & 31, hi = lane >> 5;
  int head, qrow0, nvalid, qpos0, ntiles; bool active;
  if (!samp) { head = hh; qrow0 = b * 4096 + qt * 128 + w * 32; nvalid = 32; qpos0 = qt * 128 + w * 32; ntiles = 2 * qt + 2; active = true; }
  else {
    head = hh; active = (w == 0);
    qrow0 = NP + b * 16; nvalid = 16; qpos0 = 2048; ntiles = 33;
  }
  const int qi = r32 < nvalid ? r32 : nvalid - 1;
  const int qrow = qrow0 + qi, qpos = qpos0 + qi;
  const bool lane_valid = active && (r32 < nvalid);
  const int qlast = qpos0 + nvalid - 1;
  const int klim = samp ? 2064 : ((qpos0 >> 6) + 1) * 64;
  const u16* Kg; const u16* Kg2 = nullptr; const u16* Vg = nullptr; int kpitch, vpitch; const float* Fg = nullptr;
  {
    const int TT = samp ? T_S : 4096;
    vpitch = TT;
    if (TYPE == 2) {
      kpitch = 512;
      Kg = (const u16*)(P.ws + (samp ? WS_KN_S : WS_KN_P)) + (size_t)b * TT * 512 + head * 64;
      Kg2 = (const u16*)(P.ws + (samp ? WS_KPE_S : WS_KPE_P)) + (size_t)b * TT * 32;
      Vg = (const u16*)(P.ws + (samp ? WS_VM_S : WS_VM_P)) + ((size_t)(b * 8 + head) * 64) * TT;
    } else {
      kpitch = 256;
      Kg = (const u16*)(P.ws + (TYPE == 0 ? (samp ? WS_KF_S : WS_KF_P) : (samp ? WS_KS_S : WS_KS_P))) + (size_t)b * TT * 256 + head * 64;
      Vg = (const u16*)(P.ws + (TYPE == 0 ? (samp ? WS_VFT_S : WS_VFT_P) : (samp ? WS_VST_S : WS_VST_P))) + ((size_t)(b * 4 + head) * 64) * TT;
      Fg = (const float*)(P.ws + (samp ? WS_FS : WS_FP)) + (size_t)(b * 4 + head) * TT;
    }
  }
  const bf16x8 zb = {0, 0, 0, 0, 0, 0, 0, 0};
  bf16x8 qf0 = zb, qf1 = zb, qf2 = zb, qf3 = zb, qf4 = zb, qf5 = zb, qf6 = zb, qf7 = zb, qf8 = zb, qf9 = zb;
  {
    const u16* Qp = TYPE == 0 ? B.QF + (size_t)qrow * 256 + head * 64 : TYPE == 1 ? B.QS + (size_t)qrow * 256 + head * 64 : B.QM + (size_t)qrow * 768 + head * 96;
#define QLD(s) if (s < NST) qf##s = *(const bf16x8*)(Qp + s * 16 + hi * 8);
    QLD(0) QLD(1) QLD(2) QLD(3) QLD(4) QLD(5) QLD(6) QLD(7) QLD(8) QLD(9)
#undef QLD
  }
  float zmax = INFINITY;
  if (TYPE == 0 && !samp) {
    const float4 km = *(const float4*)((const float*)(P.ws + WS_KMAX) + ((l * 8 + b) * 4 + head) * 4);
    float qn = 0.f;
#define QSQ(s) _Pragma("unroll") for (int j = 0; j < 8; ++j) { const float x = __uint_as_float(((u32)(u16)qf##s[j]) << 16); qn += x * x; }
    QSQ(0) QSQ(1) QSQ(2) QSQ(3)
#undef QSQ
    qn = halves_sum(qn);
    zmax = sqrtf(qn * (km.x + km.y + km.z + km.w)) * 1.02f + 1e-3f;
  }
  f32x16 zf;
#pragma unroll
  for (int i = 0; i < 16; ++i) zf[i] = 0.f;
  f32x16 O0 = zf, O1 = zf, O2 = zf, O3 = zf;
  float m = (TYPE == 2) ? 0.f : -INFINITY, lsum = 0.f, carry = 1.f;
  f32x16 NM = zf;
  bool first = true;
  bool wdead = !active;
  volatile int* dflags = (volatile int*)(lds + 2 * STG);
  const uint4 z4 = {0u, 0u, 0u, 0u};
  uint4 rak0 = z4, rak1 = z4, rak2 = z4, rav0 = z4, rav1 = z4; float raf_ = 0.f;
  uint4 rbk0 = z4, rbk1 = z4, rbk2 = z4, rbv0 = z4, rbv1 = z4; float rbf_ = 0.f;
#define KLD(S, i) if (i < NKC) { const int c_ = tid + 256 * i; const int row_ = (DK == 64) ? (c_ >> 3) : (c_ / 12); const int cc_ = (DK == 64) ? (c_ & 7) : (c_ - row_ * 12); \
    S##k##i = (DK == 64 || cc_ < 8) ? *(const uint4*)(Kg + (size_t)(k0_ + row_) * kpitch + cc_ * 8) : *(const uint4*)(Kg2 + (size_t)(k0_ + row_) * 32 + (cc_ - 8) * 8); }
#define VLD(S, i) { const int c_ = tid + 256 * i; S##v##i = *(const uint4*)(Vg + (size_t)(c_ >> 3) * vpitch + k0_ + (c_ & 7) * 8); }
#define ATT_PREFETCH(S, it_) { const int k0_ = ((TYPE != 2) ? ntiles - 1 - (it_) : (it_)) * 64; KLD(S, 0) KLD(S, 1) KLD(S, 2) VLD(S, 0) VLD(S, 1) if (TYPE == 0 && tid < 64) S##f_ = Fg[k0_ + tid]; }
#define KST(S, i) if (i < NKC) { const int c_ = tid + 256 * i; const int row_ = (DK == 64) ? (c_ >> 3) : (c_ / 12); const int cc_ = (DK == 64) ? (c_ & 7) : (c_ - row_ * 12); *(uint4*)(KsW + row_ * KP + cc_ * 8) = S##k##i; }
#define VST(S, i) { const int c_ = tid + 256 * i; u16* vd_ = VsW + (c_ >> 3) * VP + (c_ & 7) * 8; *(uint2*)vd_ = make_uint2(S##v##i.x, S##v##i.y); *(uint2*)(vd_ + 4) = make_uint2(S##v##i.z, S##v##i.w); }
#define ATT_STORE(S, st_) { u16* KsW = (u16*)(lds + (st_) * STG); u16* VsW = KsW + 64 * KP; float* FsW = (float*)(VsW + 64 * VP); \
    KST(S, 0) KST(S, 1) KST(S, 2) VST(S, 0) VST(S, 1) if (TYPE == 0 && tid < 64) FsW[tid] = S##f_; }
  auto tile_compute = [&](const int cur, const int it) __attribute__((always_inline)) {
    const int k0 = ((TYPE != 2) ? ntiles - 1 - it : it) * 64;
    const u16* Ks = (const u16*)(lds + cur * STG); const u16* Vs = Ks + 64 * KP; const float* Fs = (const float*)(Vs + 64 * VP);
    if (TYPE == 0 && !wdead) {
      const float bound = zmax - Fs[63];
      wdead = !__any(bound - m > -130.f);
    }
    const bool doit = active && (TYPE == 0 ? (!wdead && k0 <= qlast) : TYPE == 1 ? (!wdead && k0 < qlast) : (k0 < klim));
    if (doit) {
      f32x16 S0 = (TYPE == 2) ? NM : zf, S1 = (TYPE == 2) ? NM : zf;
      bool allzero = false;
#define SBAR __builtin_amdgcn_sched_barrier(0);
#define RD(s) bf16x8 ka##s = zb, kb##s = zb, qq##s = qf##s; if (s < NST) { ka##s = *(const bf16x8*)(Ks + r32 * KP + s * 16 + hi * 8); kb##s = *(const bf16x8*)(Ks + (32 + r32) * KP + s * 16 + hi * 8); \
                }
#define MM(s) if (s < NST) { S0 = MFMA(ka##s, qq##s, S0); S1 = MFMA(kb##s, qq##s, S1); }
      RD(0) RD(1) SBAR RD(2) SBAR MM(0) SBAR RD(3) SBAR MM(1) SBAR RD(4) SBAR MM(2) SBAR RD(5) SBAR MM(3) SBAR RD(6) SBAR MM(4) SBAR
      RD(7) SBAR MM(5) SBAR RD(8) SBAR MM(6) SBAR RD(9) SBAR MM(7) SBAR MM(8) SBAR MM(9) SBAR
#undef RD
#undef MM
      if (TYPE == 1) {
        f32x16 R0, R1;
        const bool need_mask = (k0 + 63 >= qpos0);
#pragma unroll
        for (int i = 0; i < 16; ++i) {
          const float e0 = ex2(fminf(S0[i], 60.f)), e1 = ex2(fminf(S1[i], 60.f));
          const float r0 = __builtin_amdgcn_rcpf(1.f + e0), r1 = __builtin_amdgcn_rcpf(1.f + e1);
          R0[i] = r0; R1[i] = r1; S0[i] = e0 * r0; S1[i] = e1 * r1;
        }
        if (need_mask) {
#pragma unroll
          for (int i = 0; i < 16; ++i) {
            const int key = k0 + crow(i, hi);
            if (!(key < qpos)) { R0[i] = 1.f; S0[i] = 0.f; }
            if (!(key + 32 < qpos)) { R1[i] = 1.f; S1[i] = 0.f; }
          }
        }
        float Rr = carry;
#define SBG(RV, SV, g) { \
          const float gown = (RV[4 * g] * RV[4 * g + 1]) * (RV[4 * g + 2] * RV[4 * g + 3]); \
          const float goth = __shfl_xor(gown, 32); \
          float sfx = hi ? Rr : Rr * goth; \
          SV[4 * g + 3] *= sfx; sfx *= RV[4 * g + 3]; \
          SV[4 * g + 2] *= sfx; sfx *= RV[4 * g + 2]; \
          SV[4 * g + 1] *= sfx; sfx *= RV[4 * g + 1]; \
          SV[4 * g] *= sfx; \
          Rr *= gown * goth; }
        SBG(R1, S1, 3) SBG(R1, S1, 2) SBG(R1, S1, 1) SBG(R1, S1, 0)
        SBG(R0, S0, 3) SBG(R0, S0, 2) SBG(R0, S0, 1) SBG(R0, S0, 0)
#undef SBG
        carry = Rr;
        wdead = !__any(carry != 0.f);
      } else {
        if (TYPE == 0) {
#pragma unroll
          for (int g = 0; g < 4; ++g) {
            const float4 f0 = *(const float4*)(Fs + 8 * g + 4 * hi);
            const float4 f1 = *(const float4*)(Fs + 32 + 8 * g + 4 * hi);
            S0[4 * g] -= f0.x; S0[4 * g + 1] -= f0.y; S0[4 * g + 2] -= f0.z; S0[4 * g + 3] -= f0.w;
            S1[4 * g] -= f1.x; S1[4 * g + 1] -= f1.y; S1[4 * g + 2] -= f1.z; S1[4 * g + 3] -= f1.w;
          }
          if (k0 + 63 > qpos0) {
#pragma unroll
            for (int i = 0; i < 16; ++i) {
              const int key = k0 + crow(i, hi);
              if (key > qpos) S0[i] = -INFINITY;
              if (key + 32 > qpos) S1[i] = -INFINITY;
            }
          }
        } else {
          if (k0 + 64 > klim) {
#pragma unroll
            for (int i = 0; i < 16; ++i) {
              const int key = k0 + crow(i, hi);
              if (key >= klim) S0[i] = -INFINITY;
              if (key + 32 >= klim) S1[i] = -INFINITY;
            }
          }
        }
        float mx = S0[0];
#pragma unroll
        for (int i = 1; i < 16; ++i) mx = fmaxf(mx, S0[i]);
#pragma unroll
        for (int i = 0; i < 16; ++i) mx = fmaxf(mx, S1[i]);
        mx = halves_max(mx);
        if (TYPE == 2) {
          if (first || __any(mx > 8.f)) {
            const float dm = first ? mx : fmaxf(mx, 0.f);
            if (!first) {
              const float alpha = ex2(-dm);
              lsum *= alpha;
#pragma unroll
              for (int i = 0; i < 16; ++i) { O0[i] *= alpha; O1[i] *= alpha; }
            }
            m += dm;
#pragma unroll
            for (int i = 0; i < 16; ++i) { NM[i] = -m; S0[i] -= dm; S1[i] -= dm; }
            first = false;
          }
          float ps = 0.f;
#pragma unroll
          for (int i = 0; i < 16; ++i) { S0[i] = ex2(S0[i]); S1[i] = ex2(S1[i]); ps += S0[i] + S1[i]; }
          lsum += ps;
        } else {
        if (TYPE == 0) allzero = !__any(mx - m > -130.f);
        if (__any(mx > m + 8.f)) {
          const float mnew = fmaxf(m, mx);
          const float alpha = ex2(m - mnew);
          m = mnew;
          lsum *= alpha;
#pragma unroll
          for (int i = 0; i < 16; ++i) { O0[i] *= alpha; O1[i] *= alpha; if (NDT > 2) { O2[i] *= alpha; O3[i] *= alpha; } }
        }
        if (!allzero) {
          float ps = 0.f;
#pragma unroll
          for (int i = 0; i < 16; ++i) { S0[i] = ex2(S0[i] - m); S1[i] = ex2(S1[i] - m); ps += S0[i] + S1[i]; }
          lsum += ps;
        }
        }
      }
      if (!allzero) {
      const bf16x8 pf0 = __builtin_bit_cast(bf16x8, make_uint4(pk2(S0[0], S0[1]), pk2(S0[2], S0[3]), pk2(S0[4], S0[5]), pk2(S0[6], S0[7])));
      const bf16x8 pf1 = __builtin_bit_cast(bf16x8, make_uint4(pk2(S0[8], S0[9]), pk2(S0[10], S0[11]), pk2(S0[12], S0[13]), pk2(S0[14], S0[15])));
      const bf16x8 pf2 = __builtin_bit_cast(bf16x8, make_uint4(pk2(S1[0], S1[1]), pk2(S1[2], S1[3]), pk2(S1[4], S1[5]), pk2(S1[6], S1[7])));
      const bf16x8 pf3 = __builtin_bit_cast(bf16x8, make_uint4(pk2(S1[8], S1[9]), pk2(S1[10], S1[11]), pk2(S1[12], S1[13]), pk2(S1[14], S1[15])));
      const u16* vbase = Vs + r32 * VP + 4 * hi;
#define VRD(d, sp) bf16x8 vf##d##sp = zb; if (d < NDT) { const uint2 lo = *(const uint2*)(vbase + d * 32 * VP + 16 * sp); const uint2 h8 = *(const uint2*)(vbase + d * 32 * VP + 16 * sp + 8); \
        vf##d##sp = __builtin_bit_cast(bf16x8, make_uint4(lo.x, lo.y, h8.x, h8.y)); }
#define VMM(d, sp) if (d < NDT) { O##d = MFMA(vf##d##sp, pf##sp, O##d); }
      if (TYPE == 2) __builtin_amdgcn_s_setprio(3);
      VRD(0, 0) VRD(1, 0) VRD(0, 1) SBAR VRD(1, 1) SBAR VMM(0, 0) SBAR VRD(0, 2) SBAR VMM(1, 0) SBAR VRD(1, 2) SBAR VMM(0, 1) SBAR VRD(0, 3) SBAR VMM(1, 1) SBAR VRD(1, 3) SBAR
      VMM(0, 2) SBAR VRD(2, 0) SBAR VMM(1, 2) SBAR VRD(3, 0) SBAR VMM(0, 3) SBAR VRD(2, 1) SBAR VMM(1, 3) SBAR VRD(3, 1) SBAR
      VMM(2, 0) SBAR VRD(2, 2) SBAR VMM(3, 0) SBAR VRD(3, 2) SBAR VMM(2, 1) SBAR VRD(2, 3) SBAR VMM(3, 1) SBAR VRD(3, 3) SBAR
      VMM(2, 2) SBAR VMM(3, 2) SBAR VMM(2, 3) SBAR VMM(3, 3) SBAR
      if (TYPE == 2) __builtin_amdgcn_s_setprio(0);
#undef VRD
#undef VMM
#undef SBAR
      }
    }
  };
  ATT_PREFETCH(ra, 0)
  if (ntiles > 1) { ATT_PREFETCH(rb, 1) }
  ATT_STORE(ra, 0)
  __syncthreads();
  for (int it = 0; it < ntiles; it += 2) {
    if (it + 2 < ntiles) { ATT_PREFETCH(ra, it + 2) }
    __builtin_amdgcn_sched_barrier(0);
    tile_compute(0, it);
    if (it + 1 < ntiles) { ATT_STORE(rb, 1) }
    if (TYPE != 2 && lane == 0) dflags[w] = wdead ? 1 : 0;
    __syncthreads();
    if (TYPE != 2) { if (dflags[0] & dflags[1] & dflags[2] & dflags[3]) break; }
    if (it + 1 >= ntiles) break;
    if (it + 3 < ntiles) { ATT_PREFETCH(rb, it + 3) }
    __builtin_amdgcn_sched_barrier(0);
    tile_compute(1, it + 1);
    if (it + 2 < ntiles) { ATT_STORE(ra, 0) }
    if (TYPE != 2 && lane == 0) dflags[4 + w] = wdead ? 1 : 0;
    __syncthreads();
    if (TYPE != 2) { if (dflags[4] & dflags[5] & dflags[6] & dflags[7]) break; }
  }
#undef ATT_PREFETCH
#undef ATT_STORE
#undef KLD
#undef VLD
#undef KST
#undef VST
  if (active) {
    float inv = 1.f;
    if (TYPE != 1) { const float lt = halves_sum(lsum); inv = 1.f / lt; }
    const u32 orow = (u32)qrow * 1024u;
    {
      const int goff = (TYPE == 0 ? 0 : TYPE == 1 ? 256 : 512) + head * 64;
#define OEP(d) _Pragma("unroll") for (int g = 0; g < 4; ++g) { \
          const int dd = d * 32 + 8 * g + 4 * hi; \
          const uint2 gv = *(const uint2*)(B.GATE + orow + goff + dd); \
          const float g0 = __uint_as_float(gv.x << 16), g1 = __uint_as_float(gv.x & 0xffff0000u), g2 = __uint_as_float(gv.y << 16), g3 = __uint_as_float(gv.y & 0xffff0000u); \
          uint2 o = {pk2(O##d[4 * g] * inv * g0, O##d[4 * g + 1] * inv * g1), pk2(O##d[4 * g + 2] * inv * g2, O##d[4 * g + 3] * inv * g3)}; \
          if (lane_valid) *(uint2*)(B.H + orow + goff + dd) = o; }
      OEP(0) OEP(1)
#undef OEP
    }
  }
}

constexpr int N_Q_ITEMS = 16 + 512;
DI void phase_attn(const Params& P, const Bufs& B, int ci, int l, char* lds, int* s_item, int xcc, int only_type = -1) {
  for (int qx = 0; qx < 8; ++qx) {
    const int q = (xcc + qx) & 7;
    while (true) {
      __syncthreads();
      if (threadIdx.x == 0) *s_item = (int)atomicAdd(B.ctr + ci * 8 + q, 1u);
      __syncthreads();
      const int it = *s_item;
      if (it >= N_Q_ITEMS) break;
      bool samp; int type, hh, qt; const int b = q;
      if (it < 16) {
        samp = true; qt = 0;
        if (it < 8) { type = 2; hh = it; } else if (it < 12) { type = 0; hh = it - 8; } else { type = 1; hh = it - 12; }
      } else {
        const int j = it - 16;
        samp = false;
        qt = 31 - (j >> 4); const int k16 = j & 15;
        if (k16 & 1) { type = 2; hh = k16 >> 1; } else if (k16 & 2) { type = 0; hh = k16 >> 2; } else { type = 1; hh = k16 >> 2; }
      }
      if (only_type >= 0 && type != only_type) continue;
      if (type == 0) attn_item<0>(P, B, l, samp, b, hh, qt, lds);
      else if (type == 1) attn_item<1>(P, B, l, samp, b, hh, qt, lds);
      else attn_item<2>(P, B, l, samp, b, hh, qt, lds);
    }
  }
}

__global__ void __launch_bounds__(256, 2) fwd_megakernel(Params P) {
  cg::grid_group grid = cg::this_grid();
  __shared__ __attribute__((aligned(16))) char lds[73728];
  __shared__ int s_item;
  __shared__ uint4 xb_words;
  if (threadIdx.x == 0) xb_words = make_uint4(0u, 0u, 0u, 0u);
  __syncthreads();
  const XcdBarrier xb = xcd_barrier_post((unsigned*)(P.ws + WS_BAR), (volatile LAS unsigned*)&xb_words);
  if (P.ws == nullptr) grid.sync();
  const Bufs B = make_bufs(P.ws);
  phase_prep(P, B);
  xcd_barrier(xb);
  phase_mod(P, B, lds);
  xcd_barrier(xb);
  phase_D(P, B, 0);
  xcd_barrier(xb);
#pragma unroll 1
  for (int l = 0; l < 2; ++l) {
#pragma unroll 1
    for (int rep = 0; rep <= REP_GEMM; ++rep) { EpiIn e{P, B, l}; phase_gemm(B.H, 1024, B.win + (size_t)l * 3072 * 1024, 1024, 1024, 24, lds, e, true); }
    xcd_barrier(xb);
    phase_A2a(P, B, l, lds);
    xcd_barrier(xb);
#pragma unroll 1
    for (int rep = 0; rep <= REP_GEMM; ++rep) phase_A2b(P, B, l, lds);
    xcd_barrier(xb);
#pragma unroll 1
    for (int rep = 0; rep <= REP_ATTN; ++rep) { phase_attn(P, B, l + 2 * rep, l, lds, &s_item, (int)xb.x, rep ? 2 : -1); if (rep < REP_ATTN) xcd_barrier(xb); }
    xcd_barrier(xb);
#pragma unroll 1
    for (int rep = 0; rep <= REP_GEMM; ++rep) { EpiY e{B}; phase_gemm(B.H, 1024, B.wout + (size_t)l * 1024 * 1024, 1024, 1024, 8, lds, e, false); }
    xcd_barrier(xb);
    phase_D(P, B, l + 1);
    if (l == 0) xcd_barrier(xb);
  }
}

extern "C" void kernel_launch(void* const* d_in, const int* in_sizes, int n_in,
                              void* d_out, int out_size, void* d_ws, size_t ws_size,
                              hipStream_t stream) {
  static int grid_blocks = 0;
  if (!grid_blocks) {
    int dev = 0, cus = 0, per_cu = 0;
    (void)hipGetDevice(&dev);
    (void)hipDeviceGetAttribute(&cus, hipDeviceAttributeMultiprocessorCount, dev);
    (void)hipOccupancyMaxActiveBlocksPerMultiprocessor(&per_cu, fwd_megakernel, 256, 0);
    if (per_cu > 2) per_cu = 2;
    if (per_cu < 1) per_cu = 1;
    grid_blocks = cus * per_cu;
    if (ws_size < WS_END) fprintf(stderr, "workspace too small: %zu < %zu\n", ws_size, (size_t)WS_END);
  }
  Params p{};
  const float** pp = (const float**)&p;
  for (int i = 0; i < 23; ++i) pp[i] = (const float*)d_in[i];
  p.out = (float*)d_out;
  p.ws = (unsigned char*)d_ws;
  (void)hipMemsetAsync((char*)d_ws + WS_CTR, 0, 256 + 16384, stream);
  void* args[] = {&p};
  hipError_t e = hipLaunchCooperativeKernel((void*)fwd_megakernel, dim3(grid_blocks), dim3(256), args, 0, stream);
  if (e != hipSuccess) fprintf(stderr, "cooperative launch failed: %s (grid %d)\n", hipGetErrorString(e), grid_blocks);
}
```
